# Optimizing an MI355X kernel written in HIP

```python
import jax, jax.numpy as jnp
from jax import lax
import numpy as np

D_MODEL = 1024
BATCH = 16
SEQ = 4096
DEPTH = 2

N_EVEN = (DEPTH + 1) // 2
N_ODD = DEPTH // 2
D_FF = 4 * D_MODEL
NORM_EPS = 1e-6
CHUNK = 128

RWKV_WIDTH = D_MODEL // 2
RWKV_HEAD_DIM = 64
RWKV_HEADS = RWKV_WIDTH // RWKV_HEAD_DIM
DECAY_LORA = 64
ICL_LORA = 64
GATE_LORA = 128
RWKV_GN_EPS = 64e-5
RWKV_COLS = 3 * RWKV_WIDTH + DECAY_LORA + ICL_LORA + GATE_LORA

RET_WIDTH = D_MODEL - RWKV_WIDTH
RET_HEADS = 4
RET_HEAD_DIM = RET_WIDTH // RET_HEADS
ROPE_BASE = 10000.0
RET_COLS = 4 * RET_WIDTH
AB_COLS = RWKV_COLS + RET_COLS

MLSTM_HEADS = 8
MLSTM_QK_DIM = D_MODEL // 2 // MLSTM_HEADS
MLSTM_V_DIM = D_MODEL // MLSTM_HEADS
MLSTM_CONV = 4
GATE_SOFTCAP = 15.0
MLSTM_QK_COLS = 2 * MLSTM_HEADS * MLSTM_QK_DIM
C_COLS = MLSTM_QK_COLS + 2 * D_MODEL + 2 * MLSTM_HEADS

kernel_name = 'hybrid_rwkv7_retention_mlstm_trunk'

F32 = jnp.float32


def rms_norm(x, g):
    xf = x.astype(F32)
    y = xf * lax.rsqrt(jnp.mean(xf * xf, axis=-1, keepdims=True) + NORM_EPS)
    return (y * g.astype(F32)).astype(x.dtype)


def token_shift(x):
    return jnp.pad(x, ((0, 0), (1, 0), (0, 0)))[:, :-1]


def split_heads(x, n_heads):
    return x.reshape(x.shape[:-1] + (n_heads, x.shape[-1] // n_heads))


def rwkv7_scan(r, decay, k, v, a, b):
    bsz, _, n_heads, n = r.shape
    xs = tuple(jnp.moveaxis(t, 1, 0) for t in (r, decay, k, v, a, b))

    def step(state, inp):
        r_t, w_t, k_t, v_t, a_t, b_t = inp
        sa = jnp.einsum('bhij,bhj->bhi', state, a_t)
        state = (state * w_t[:, :, None, :] + sa[..., None] * b_t[:, :, None, :]
                 + v_t[..., None] * k_t[:, :, None, :])
        return state, jnp.einsum('bhij,bhj->bhi', state, r_t)

    s0 = jnp.zeros((bsz, n_heads, n, n), F32)
    _, y = lax.scan(step, s0, xs)
    return jnp.moveaxis(y, 0, 1)


def rwkv7_group(p, mu, w0, w_up, a0, a_up, g_up, k_k, k_a, r_k, ln_w, ln_b):
    bsz, seq, _ = p.shape
    p = p + (token_shift(p) - p) * mu
    cuts = [RWKV_WIDTH, 2 * RWKV_WIDTH, 3 * RWKV_WIDTH,
            3 * RWKV_WIDTH + DECAY_LORA, 3 * RWKV_WIDTH + DECAY_LORA + ICL_LORA]
    r, k, v, w_lo, a_lo, g_lo = jnp.split(p, cuts, axis=-1)
    w = -jax.nn.softplus(-(w0 + jnp.tanh(w_lo) @ w_up)) - 0.5
    decay = jnp.exp(-jnp.exp(w.astype(F32)))
    a = jax.nn.sigmoid(a0 + a_lo @ a_up)
    g = jax.nn.sigmoid(g_lo) @ g_up
    kk = split_heads((k * k_k).astype(F32), RWKV_HEADS)
    kk = kk * lax.rsqrt(jnp.maximum(jnp.sum(kk * kk, -1, keepdims=True), 1e-24))
    k = k * (1.0 + (a - 1.0) * k_a)
    rh, kh, vh, ah = [split_heads(t.astype(F32), RWKV_HEADS) for t in (r, k, v, a)]
    dh = split_heads(decay, RWKV_HEADS)
    y = rwkv7_scan(rh, dh, kh, vh, -kk, kk * ah)
    mean = jnp.mean(y, -1, keepdims=True)
    var = jnp.mean(jnp.square(y - mean), -1, keepdims=True)
    y = (y - mean) * lax.rsqrt(var + RWKV_GN_EPS)
    y = y.reshape(bsz, seq, RWKV_WIDTH) * ln_w + ln_b
    bonus = jnp.sum(rh * kh * r_k, -1, keepdims=True) * vh
    y = (y + bonus.reshape(bsz, seq, RWKV_WIDTH)) * g
    return y.astype(p.dtype)


def rotary(x, pos):
    d = x.shape[-1]
    inv = ROPE_BASE ** (-jnp.arange(0, d, 2, dtype=F32) / d)
    ang = pos[:, None] * inv[None, :]
    cos = jnp.cos(ang)[None, :, None, :]
    sin = jnp.sin(ang)[None, :, None, :]
    x1, x2 = x[..., : d // 2], x[..., d // 2:]
    return jnp.concatenate([x1 * cos - x2 * sin, x1 * sin + x2 * cos], axis=-1)


def chunk_bthd(x):
    bsz, seq, h, d = x.shape
    return x.reshape(bsz, seq // CHUNK, CHUNK, h, d).transpose(1, 0, 3, 2, 4)


def unchunk_bthd(x):
    nc, bsz, h, l, d = x.shape
    return x.transpose(1, 0, 3, 2, 4).reshape(bsz, nc * l, h, d)


def retention_chunkwise(q, k, v):
    bsz, _, n_heads, d = q.shape
    log_gamma = jnp.log1p(-jnp.exp2(-5.0 - jnp.arange(n_heads, dtype=F32)))
    idx = jnp.arange(CHUNK, dtype=F32)
    rel = idx[:, None] - idx[None, :]
    causal = rel >= 0
    decay_mat = jnp.where(causal[None], jnp.exp(log_gamma[:, None, None] * jnp.where(causal, rel, 0.0)[None]), 0.0)
    q_decay = jnp.exp(log_gamma[:, None] * (idx + 1.0)[None])
    k_decay = jnp.exp(log_gamma[:, None] * (CHUNK - 1.0 - idx)[None])
    chunk_decay = jnp.exp(log_gamma * CHUNK)

    def step(state, inp):
        qc, kc, vc = inp
        s = jnp.einsum('bhld,bhmd->bhlm', qc, kc) * decay_mat
        o = (jnp.einsum('bhlm,bhme->bhle', s, vc)
             + jnp.einsum('bhld,bhde->bhle', qc, state) * q_decay[None, :, :, None])
        state = (state * chunk_decay[None, :, None, None]
                 + jnp.einsum('bhmd,bhme->bhde', kc * k_decay[None, :, :, None], vc))
        return state, o

    s0 = jnp.zeros((bsz, n_heads, d, d), F32)
    _, o = lax.scan(step, s0, (chunk_bthd(q), chunk_bthd(k), chunk_bthd(v)))
    return unchunk_bthd(o)


def retention_group(p, pos):
    bsz, seq, _ = p.shape
    q, k, v, g = jnp.split(p, 4, axis=-1)
    q = rotary(split_heads(q.astype(F32), RET_HEADS), pos)
    k = rotary(split_heads(k.astype(F32), RET_HEADS), pos) * (RET_HEAD_DIM ** -0.5)
    v = split_heads(v.astype(F32), RET_HEADS)
    o = retention_chunkwise(q, k, v)
    o = o * lax.rsqrt(jnp.mean(o * o, -1, keepdims=True) + NORM_EPS)
    y = o.reshape(bsz, seq, RET_WIDTH) * jax.nn.silu(g.astype(F32))
    return y.astype(p.dtype)


def causal_depthwise_conv(x, w, b):
    n_taps = w.shape[0]
    seq = x.shape[1]
    xp = jnp.pad(x, ((0, 0), (n_taps - 1, 0), (0, 0)))
    return sum(xp[:, j:j + seq] * w[j] for j in range(n_taps)) + b


def to_chunks(x):
    bsz, h, seq = x.shape[:3]
    x = x.reshape((bsz, h, seq // CHUNK, CHUNK) + x.shape[3:])
    return jnp.moveaxis(x, 2, 0)


def from_chunks(x):
    x = jnp.moveaxis(x, 0, 2)
    return x.reshape(x.shape[:2] + (x.shape[2] * x.shape[3],) + x.shape[4:])


def mlstm_chunkwise(q, k, v, log_i, log_f):
    bsz, n_heads, _, dk = q.shape
    dv = v.shape[-1]
    causal = jnp.tril(jnp.ones((CHUNK, CHUNK), bool))

    def step(carry, inp):
        c_st, n_st, m_st = carry
        qc, kc, vc, li, lf = inp
        b = jnp.cumsum(lf, axis=-1)
        log_d = jnp.where(causal, b[..., :, None] - b[..., None, :] + li[..., None, :], -jnp.inf)
        log_inter = b + m_st[..., None]
        m_t = jnp.maximum(jnp.max(log_d, axis=-1), log_inter)
        s = jnp.einsum('bhld,bhsd->bhls', qc, kc) * jnp.exp(log_d - m_t[..., None])
        inter = jnp.exp(log_inter - m_t)
        num = (jnp.einsum('bhls,bhse->bhle', s, vc)
               + inter[..., None] * jnp.einsum('bhld,bhde->bhle', qc, c_st))
        den = jnp.sum(s, axis=-1) + inter * jnp.einsum('bhld,bhd->bhl', qc, n_st)
        h = num / jnp.maximum(jnp.abs(den), jnp.exp(-m_t))[..., None]
        b_end = b[..., -1]
        log_w = b_end[..., None] - b + li
        m_new = jnp.maximum(b_end + m_st, jnp.max(log_w, axis=-1))
        kw = kc * jnp.exp(log_w - m_new[..., None])[..., None]
        carry_scale = jnp.exp(b_end + m_st - m_new)
        c_st = carry_scale[..., None, None] * c_st + jnp.einsum('bhsd,bhse->bhde', kw, vc)
        n_st = carry_scale[..., None] * n_st + jnp.sum(kw, axis=2)
        return (c_st, n_st, m_new), h

    carry0 = (jnp.zeros((bsz, n_heads, dk, dv), F32),
              jnp.zeros((bsz, n_heads, dk), F32),
              jnp.zeros((bsz, n_heads), F32))
    xs = (to_chunks(q), to_chunks(k), to_chunks(v), to_chunks(log_i), to_chunks(log_f))
    _, h = lax.scan(step, carry0, xs)
    return from_chunks(h)


def softcap(x):
    return GATE_SOFTCAP * jnp.tanh(x / GATE_SOFTCAP)


def mlstm_group(p, conv_w, conv_b, i_bias, f_bias, norm_w):
    bsz, seq, _ = p.shape
    cuts = [MLSTM_QK_COLS, MLSTM_QK_COLS + D_MODEL, MLSTM_QK_COLS + 2 * D_MODEL,
            MLSTM_QK_COLS + 2 * D_MODEL + MLSTM_HEADS]
    qk, v, o, i_pre, f_pre = jnp.split(p, cuts, axis=-1)
    qk = jax.nn.silu(causal_depthwise_conv(qk, conv_w, conv_b))
    q, k = jnp.split(qk.astype(F32), 2, axis=-1)
    q = split_heads(q, MLSTM_HEADS).transpose(0, 2, 1, 3)
    k = split_heads(k, MLSTM_HEADS).transpose(0, 2, 1, 3) * (MLSTM_QK_DIM ** -0.5)
    vh = split_heads(v.astype(F32), MLSTM_HEADS).transpose(0, 2, 1, 3)
    log_i = softcap((i_pre + i_bias).astype(F32)).transpose(0, 2, 1)
    log_f = jax.nn.log_sigmoid(softcap((f_pre + f_bias).astype(F32))).transpose(0, 2, 1)
    h = mlstm_chunkwise(q, k, vh, log_i, log_f).transpose(0, 2, 1, 3)
    h = h * lax.rsqrt(jnp.mean(h * h, -1, keepdims=True) + NORM_EPS)
    h = h * norm_w.astype(F32).reshape(MLSTM_HEADS, MLSTM_V_DIM)
    y = h.reshape(bsz, seq, D_MODEL) * jax.nn.sigmoid(o.astype(F32))
    return y.astype(p.dtype)


def squared_relu_mlp(h, w1, w2):
    return jnp.square(jax.nn.relu(h @ w1)) @ w2


def setup_inputs(seed: int = 0) -> dict:
    key = jax.random.key(seed)
    ks = jax.random.split(key, 32)
    nrm = jax.random.normal
    uni = jax.random.uniform
    E, O, D = N_EVEN, N_ODD, D_MODEL
    return {
        'x': nrm(ks[0], (BATCH, SEQ, D), F32),
        'norm_mix_g': 1.0 + 0.02 * nrm(ks[1], (DEPTH, D), F32),
        'norm_mlp_g': 1.0 + 0.02 * nrm(ks[2], (DEPTH, D), F32),
        'norm_final_g': 1.0 + 0.02 * nrm(ks[3], (D,), F32),
        'ab_w_in': nrm(ks[4], (E, D, AB_COLS), F32) * D ** -0.5,
        'rwkv_mu': uni(ks[5], (E, RWKV_COLS), F32),
        'rwkv_w0': uni(ks[6], (E, RWKV_WIDTH), F32, minval=-6.5, maxval=-1.5),
        'rwkv_w_up': nrm(ks[7], (E, DECAY_LORA, RWKV_WIDTH), F32) * 0.1 * DECAY_LORA ** -0.5,
        'rwkv_a0': 0.1 * nrm(ks[8], (E, RWKV_WIDTH), F32),
        'rwkv_a_up': nrm(ks[9], (E, ICL_LORA, RWKV_WIDTH), F32) * ICL_LORA ** -0.5,
        'rwkv_g_up': nrm(ks[10], (E, GATE_LORA, RWKV_WIDTH), F32) * GATE_LORA ** -0.5,
        'rwkv_k_k': 0.85 + 0.05 * nrm(ks[11], (E, RWKV_WIDTH), F32),
        'rwkv_k_a': 1.0 + 0.05 * nrm(ks[12], (E, RWKV_WIDTH), F32),
        'rwkv_r_k': 0.1 * nrm(ks[13], (E, RWKV_HEADS, RWKV_HEAD_DIM), F32),
        'rwkv_ln_w': 1.0 + 0.02 * nrm(ks[14], (E, RWKV_WIDTH), F32),
        'rwkv_ln_b': 0.02 * nrm(ks[15], (E, RWKV_WIDTH), F32),
        'ab_w_out': nrm(ks[16], (E, D, D), F32) * D ** -0.5,
        'c_w_in': nrm(ks[17], (O, D, C_COLS), F32) * D ** -0.5,
        'c_conv_w': nrm(ks[18], (O, MLSTM_CONV, MLSTM_QK_COLS), F32) * MLSTM_CONV ** -0.5,
        'c_conv_b': 0.02 * nrm(ks[19], (O, MLSTM_QK_COLS), F32),
        'c_i_bias': 0.1 * nrm(ks[20], (O, MLSTM_HEADS), F32),
        'c_f_bias': uni(ks[21], (O, MLSTM_HEADS), F32, minval=3.0, maxval=6.0),
        'c_norm_w': 1.0 + 0.02 * nrm(ks[22], (O, D), F32),
        'c_w_out': nrm(ks[23], (O, D, D), F32) * D ** -0.5,
        'mlp_w1': nrm(ks[24], (DEPTH, D, D_FF), F32) * D ** -0.5,
        'mlp_w2': nrm(ks[25], (DEPTH, D_FF, D), F32) * D_FF ** -0.5,
    }


def reference(x, norm_mix_g, norm_mlp_g, norm_final_g, ab_w_in, rwkv_mu, rwkv_w0,
              rwkv_w_up, rwkv_a0, rwkv_a_up, rwkv_g_up, rwkv_k_k, rwkv_k_a, rwkv_r_k,
              rwkv_ln_w, rwkv_ln_b, ab_w_out, c_w_in, c_conv_w, c_conv_b, c_i_bias,
              c_f_bias, c_norm_w, c_w_out, mlp_w1, mlp_w2):
    seq = x.shape[1]
    pos = jnp.arange(seq, dtype=F32)
    for layer in range(DEPTH):
        h = rms_norm(x, norm_mix_g[layer])
        j = layer // 2
        if layer % 2 == 0:
            p = h @ ab_w_in[j]
            y_a = rwkv7_group(p[..., :RWKV_COLS], rwkv_mu[j], rwkv_w0[j], rwkv_w_up[j],
                              rwkv_a0[j], rwkv_a_up[j], rwkv_g_up[j], rwkv_k_k[j],
                              rwkv_k_a[j], rwkv_r_k[j], rwkv_ln_w[j], rwkv_ln_b[j])
            y_b = retention_group(p[..., RWKV_COLS:], pos)
            y = jnp.concatenate([y_a, y_b], axis=-1) @ ab_w_out[j]
        else:
            p = h @ c_w_in[j]
            y = mlstm_group(p, c_conv_w[j], c_conv_b[j], c_i_bias[j], c_f_bias[j],
                            c_norm_w[j]) @ c_w_out[j]
        x = x + y.astype(x.dtype)
        h = rms_norm(x, norm_mlp_g[layer])
        x = x + squared_relu_mlp(h, mlp_w1[layer], mlp_w2[layer]).astype(x.dtype)
    return rms_norm(x, norm_final_g)
```

```cpp
#include <hip/hip_runtime.h>
#include <hip/hip_cooperative_groups.h>
#include <cstdint>
#include <cstdio>
namespace cg = cooperative_groups;

typedef unsigned short bf16_t;
typedef short bf16x8 __attribute__((ext_vector_type(8)));
typedef float f32x4 __attribute__((ext_vector_type(4)));
typedef unsigned u32x4 __attribute__((ext_vector_type(4)));
typedef unsigned u32x2 __attribute__((ext_vector_type(2)));

constexpr int MTOK = 65536, SEQ = 4096;
constexpr size_t MB = 1024 * 1024;
constexpr size_t WS_WT_AB = 0;
constexpr size_t WS_WT_ABO = WS_WT_AB + 3840 * 1024 * 2;
constexpr size_t WS_WT_W1_0 = WS_WT_ABO + 1024 * 1024 * 2;
constexpr size_t WS_WT_W2_0 = WS_WT_W1_0 + 4096 * 1024 * 2;
constexpr size_t WS_WT_C = WS_WT_W2_0 + 4096 * 1024 * 2;
constexpr size_t WS_WT_CO = WS_WT_C + 3328 * 1024 * 2;
constexpr size_t WS_WT_W1_1 = WS_WT_CO + 1024 * 1024 * 2;
constexpr size_t WS_WT_W2_1 = WS_WT_W1_1 + 4096 * 1024 * 2;
constexpr size_t WS_WT_LORA = WS_WT_W2_1 + 4096 * 1024 * 2;
constexpr size_t WS_COS = WS_WT_LORA + 1536 * 256 * 2;
constexpr size_t WS_SIN = WS_COS + 4096 * 64 * 4;
constexpr size_t WS_GATES = WS_SIN + 4096 * 64 * 4;
constexpr size_t WS_BAR = WS_GATES + (size_t)MTOK * 16 * 4;
constexpr size_t WS_BAR_BYTES = 16384;
constexpr size_t WS_R2 = WS_BAR + WS_BAR_BYTES;
constexpr size_t WS_A_END = WS_R2 + (size_t)3 * MTOK * 8;
static_assert(WS_A_END <= 60 * MB, "region A");
constexpr size_t WS_H = 60 * MB;
constexpr size_t WS_C = 188 * MB;
constexpr size_t WS_D = 444 * MB;
constexpr size_t WS_D_PRW = WS_D;
constexpr size_t WS_D_W = WS_D_PRW + (size_t)MTOK * 1792 * 2;
constexpr size_t WS_D_AG = WS_D_W + (size_t)MTOK * 512 * 2;
constexpr size_t WS_D_G = WS_D_AG + (size_t)MTOK * 512 * 2;
constexpr size_t WS_D_L = WS_D_G + (size_t)MTOK * 512 * 2;
static_assert(WS_D_L + (size_t)MTOK * 256 * 2 <= WS_D + 512 * MB, "region D");

struct Params {
    const float* x; const float* norm_mix_g; const float* norm_mlp_g; const float* norm_final_g;
    const float* ab_w_in; const float* rwkv_mu; const float* rwkv_w0; const float* rwkv_w_up; const float* rwkv_a0; const float* rwkv_a_up;
    const float* rwkv_g_up; const float* rwkv_k_k; const float* rwkv_k_a; const float* rwkv_r_k; const float* rwkv_ln_w; const float* rwkv_ln_b;
    const float* ab_w_out; const float* c_w_in; const float* c_conv_w; const float* c_conv_b; const float* c_i_bias; const float* c_f_bias;
    const float* c_norm_w; const float* c_w_out; const float* mlp_w1; const float* mlp_w2;
    float* out; unsigned char* ws;
};

typedef const Params __attribute__((address_space(4)))* KP;
__device__ __forceinline__ KP launder(KP p) { asm volatile("" : "+s"(p)); return p; }
__device__ __forceinline__ int launder_tid(const int wvs) { int l; asm volatile("v_mbcnt_lo_u32_b32 %0, -1, 0\n\tv_mbcnt_hi_u32_b32 %0, -1, %0" : "=v"(l)); return wvs * 64 + l; }
extern __shared__ __attribute__((aligned(16))) unsigned char smem[];

__device__ __forceinline__ unsigned pk2(float lo, float hi) { unsigned r; asm("v_cvt_pk_bf16_f32 %0, %1, %2" : "=v"(r) : "v"(lo), "v"(hi)); return r; }
__device__ __forceinline__ u32x4 pk8(const f32x4 a, const f32x4 b) { u32x4 w; w.x = pk2(a[0], a[1]); w.y = pk2(a[2], a[3]); w.z = pk2(b[0], b[1]); w.w = pk2(b[2], b[3]); return w; }
__device__ __forceinline__ bf16_t f2bf(float f) { return (bf16_t)(pk2(f, 0.f) & 0xffffu); }
__device__ __forceinline__ float bflo(unsigned u) { return __uint_as_float(u << 16); }
__device__ __forceinline__ float bfhi(unsigned u) { return __uint_as_float(u & 0xffff0000u); }
__device__ __forceinline__ float sigmoidf_(float z) { return 1.f / (1.f + __expf(-z)); }
__device__ __forceinline__ float sigmoid_fast(float z) { return __builtin_amdgcn_rcpf(1.f + __expf(-z)); }
template <int CTRL> __device__ __forceinline__ float dpp_add(float v) {
    return v + __builtin_bit_cast(float, __builtin_amdgcn_update_dpp(0, __builtin_bit_cast(int, v), CTRL, 0xf, 0xf, false));
}
__device__ __forceinline__ float red8(float v) { v = dpp_add<0xB1>(v); v = dpp_add<0x4E>(v); v = dpp_add<0x141>(v); return v; }
__device__ __forceinline__ float red16(float v) { v += __shfl_xor(v, 1); v += __shfl_xor(v, 2); v += __shfl_xor(v, 4); v += __shfl_xor(v, 8); return v; }
__device__ __forceinline__ float wave_sum(float v) { v = red16(v); v += __shfl_xor(v, 16); v += __shfl_xor(v, 32); return v; }

constexpr int BM = 256, BK = 64, HALF = 128, HT = HALF * BK, GEMM_LDS = 8 * HT * 2;
__device__ __forceinline__ int lds_byte(int r, int c) { int st = (r >> 4) * 2 + (c >> 5), rr = r & 15, cc = c & 31, ob = rr * 64 + cc * 2; return st * 1024 + (ob ^ (((ob >> 9) & 1) << 5)); }
__device__ __forceinline__ void stage_rc(int b, int& R, int& C) { int st = b / 1024, sb = b % 1024, swz = sb ^ (((sb >> 9) & 1) << 5); R = (st >> 1) * 16 + swz / 64; C = (st & 1) * 32 + (swz % 64) / 2; }

template <int N, int K, class Epi, bool PADSKIP = false>
__device__ __forceinline__ void gemm_phase(const bf16_t* __restrict__ A, const bf16_t* __restrict__ Bt, const Epi epi, const int wvs) {
    typedef __attribute__((address_space(3))) unsigned char lds_u8;
    typedef __attribute__((address_space(3))) unsigned lds_u32;
    typedef __attribute__((address_space(3))) bf16x8 lds_bf16x8;
    lds_u8* lds = (lds_u8*)smem;
    constexpr int HTB = HALF * BK * 2;
    constexpr int nN = N / BM, ntiles = (MTOK / BM) * nN, nt = K / BK;
    const int tid = launder_tid(wvs), wid = wvs, lane = tid & 63, wr = wid >> 2, wc = wid & 3, fr = lane & 15, fq = lane >> 4;
    unsigned voff[2], voffB[2];
#pragma unroll
    for (int i = 0; i < 2; ++i) { int R, C; stage_rc(tid * 16 + i * 8192, R, C); voff[i] = (unsigned)(R * K + C) * 2u;
        const int rho = R & 31, Rb = Epi::PERM ? ((R & ~31) + 8 * ((rho & 15) >> 2) + 4 * (rho >> 4) + (rho & 3)) : R; voffB[i] = (unsigned)(Rb * K + C) * 2u; }
    constexpr size_t kstep = (size_t)(BK * 2), hstep = (size_t)HALF * K * 2, tstep = 2 * hstep;
    const unsigned ldsw = (unsigned)wid * 1024u;
    const int aoff = lds_byte(wr * 64 + fr, fq * 8), boff = lds_byte(wc * 32 + fr, fq * 8);
#define PG8_SA(b, h) (((b) * 2 + (h)) * HTB)
#define PG8_SB(b, h) ((4 + (b) * 2 + (h)) * HTB)
#define PG8_STAGE(bufoff, gbase) PG8_STAGEV(bufoff, gbase, voff)
#define PG8_STAGEV(bufoff, gbase, vo_) do { _Pragma("unroll") for (int _i = 0; _i < 2; ++_i) \
        __builtin_amdgcn_global_load_lds((const unsigned*)((const char*)(gbase) + vo_[_i]), (lds_u32*)(lds + (bufoff) + ldsw + _i * 8192), 16, 0, 0); } while (0)
#define PG8_LDA(dst, b, h) do { _Pragma("unroll") for (int m = 0; m < 4; ++m) _Pragma("unroll") for (int k = 0; k < 2; ++k) dst[m][k] = *(const lds_bf16x8*)(lds + PG8_SA(b, h) + aoff + m * 2048 + k * 1024); } while (0)
#define PG8_LDB(dst, b, h) do { _Pragma("unroll") for (int n = 0; n < 2; ++n) _Pragma("unroll") for (int k = 0; k < 2; ++k) dst[n][k] = *(const lds_bf16x8*)(lds + PG8_SB(b, h) + boff + n * 2048 + k * 1024); } while (0)
#define PG8_MMA(ai, bj, At, Bt_) do { __builtin_amdgcn_s_setprio(1); _Pragma("unroll") for (int m = 0; m < 4; ++m) _Pragma("unroll") for (int n = 0; n < 2; ++n) _Pragma("unroll") for (int k = 0; k < 2; ++k) \
        acc[ai][bj][m][n] = __builtin_amdgcn_mfma_f32_16x16x32_bf16(Bt_[n][k], At[m][k], acc[ai][bj][m][n], 0, 0, 0); __builtin_amdgcn_s_setprio(0); } while (0)
#define PG8_WAIT_V(n) asm volatile("s_waitcnt vmcnt(" #n ")" ::: "memory")
#define PG8_WAIT_L(n) asm volatile("s_waitcnt lgkmcnt(" #n ")" ::: "memory")
#define PG8_BAR __builtin_amdgcn_s_barrier()
#define PG8_SCHED __builtin_amdgcn_sched_barrier(0)
#define PG8_TILE(t_, pm_, pn_) do { const int w_ = ((t_) & 7) * (ntiles / 8) + ((t_) >> 3); const int g_ = w_ / (8 * nN), r_ = w_ - g_ * (8 * nN); pm_ = g_ * 8 + (r_ & 7); pn_ = r_ >> 3; } while (0)
    int tile = blockIdx.x;
    if (tile >= ntiles) return;
    int cpm, cpn; PG8_TILE(tile, cpm, cpn);
    f32x4 acc[2][2][4][2];
#pragma unroll
    for (int a_ = 0; a_ < 2; ++a_)
#pragma unroll
        for (int b_ = 0; b_ < 2; ++b_)
#pragma unroll
            for (int m = 0; m < 4; ++m)
#pragma unroll
                for (int n = 0; n < 2; ++n) acc[a_][b_][m][n] = (f32x4){0.f, 0.f, 0.f, 0.f};
    bf16x8 At[4][2], B0[2][2], B1[2][2];
    const char* cA = (const char*)A + (size_t)cpm * tstep; const char* cB = (const char*)Bt + (size_t)cpn * tstep;
    PG8_STAGEV(PG8_SB(0, 0), cB, voffB); PG8_STAGEV(PG8_SB(0, 1), cB + hstep, voffB); PG8_STAGE(PG8_SA(0, 0), cA); PG8_STAGE(PG8_SA(0, 1), cA + hstep);
    if (wr == 1) PG8_BAR;
    PG8_WAIT_V(2); PG8_BAR;
    PG8_STAGEV(PG8_SB(1, 0), cB + kstep, voffB); PG8_STAGE(PG8_SA(1, 0), cA + kstep); PG8_STAGEV(PG8_SB(1, 1), cB + hstep + kstep, voffB);
    PG8_WAIT_V(6); PG8_BAR;
    for (;;) {
        const int ntile = tile + gridDim.x; const bool has_next = ntile < ntiles;
        int npm = cpm, npn = cpn; if (has_next) PG8_TILE(ntile, npm, npn);
        const char* nA = (const char*)A + (size_t)npm * tstep; const char* nB = (const char*)Bt + (size_t)npn * tstep;
        for (int t = 0; t < nt; t += 2) {
            const bool last = (t == nt - 2);
            const char* a1 = cA + (size_t)(t + 1) * kstep;
            const char* a2 = last ? nA : cA + (size_t)(t + 2) * kstep; const char* b2 = last ? nB : cB + (size_t)(t + 2) * kstep;
            const char* a3 = a2 + kstep; const char* b3 = b2 + kstep;
            PG8_LDB(B0, 0, 0); PG8_LDB(B1, 0, 1); PG8_SCHED; PG8_LDA(At, 0, 0); PG8_STAGE(PG8_SA(1, 1), a1 + hstep);
            PG8_WAIT_V(8); PG8_WAIT_L(0); PG8_BAR; PG8_MMA(0, 0, At, B0); if (!(PADSKIP && cpn == nN - 1)) PG8_MMA(0, 1, At, B1); PG8_BAR; PG8_SCHED;
            PG8_LDA(At, 0, 1); PG8_STAGEV(PG8_SB(0, 0), b2, voffB); PG8_STAGEV(PG8_SB(0, 1), b2 + hstep, voffB); PG8_STAGE(PG8_SA(0, 0), a2);
            PG8_WAIT_V(8); PG8_WAIT_L(0); PG8_BAR; PG8_MMA(1, 0, At, B0); if (!(PADSKIP && cpn == nN - 1)) PG8_MMA(1, 1, At, B1); PG8_BAR; PG8_SCHED;
            PG8_LDB(B0, 1, 0); PG8_LDB(B1, 1, 1); PG8_SCHED; PG8_LDA(At, 1, 0); PG8_STAGE(PG8_SA(0, 1), a2 + hstep);
            PG8_WAIT_V(8); PG8_WAIT_L(0); PG8_BAR; PG8_MMA(0, 0, At, B0); if (!(PADSKIP && cpn == nN - 1)) PG8_MMA(0, 1, At, B1); PG8_BAR; PG8_SCHED;
            PG8_LDA(At, 1, 1); PG8_STAGEV(PG8_SB(1, 0), b3, voffB); PG8_STAGEV(PG8_SB(1, 1), b3 + hstep, voffB); PG8_STAGE(PG8_SA(1, 0), a3);
            PG8_WAIT_V(8); PG8_WAIT_L(0); PG8_BAR; PG8_MMA(1, 0, At, B0); if (!(PADSKIP && cpn == nN - 1)) PG8_MMA(1, 1, At, B1); PG8_BAR; PG8_SCHED;
        }
        if (wr == 0) PG8_BAR;
        {
            const int tid_e = launder_tid(wvs), wr_e = (tid_e >> 8) & 1, wc_e = (tid_e >> 6) & 3, fr_e = tid_e & 15, fq_e = (tid_e >> 4) & 3;
            const int brow = cpm * BM, bcol = cpn * BM; float rowss = 0.f; (void)rowss;
            volatile __attribute__((address_space(3))) float* rsL = (volatile __attribute__((address_space(3))) float*)(lds + GEMM_LDS + 64);
            if constexpr (Epi::ROWSCALE) {
                if (tid_e < 256) rsL[tid_e] = epi.rowscale(brow + tid_e);
                PG8_WAIT_L(0); PG8_BAR; asm volatile("" ::: "memory");
            }
#pragma unroll
            for (int ai = 0; ai < 2; ++ai)
#pragma unroll
                for (int m = 0; m < 4; ++m)
#pragma unroll
                    for (int bj = 0; bj < 2; ++bj) {
                        if constexpr (Epi::ROWSCALE) epi.op8s(brow + ai * HALF + wr_e * 64 + m * 16 + fr_e, bcol + bj * HALF + wc_e * 32 + fq_e * 8, acc[ai][bj][m][0], acc[ai][bj][m][1], rsL[ai * HALF + wr_e * 64 + m * 16 + fr_e]);
                        else if constexpr (Epi::ROWSS) { const float ss_ = epi.op8r(brow + ai * HALF + wr_e * 64 + m * 16 + fr_e, bcol + bj * HALF + wc_e * 32 + fq_e * 8, acc[ai][bj][m][0], acc[ai][bj][m][1]);
                            if (bj == 0) rowss = ss_; else epi.rowdone(brow + ai * HALF + wr_e * 64 + m * 16 + fr_e, rowss + ss_, fq_e); }
                        else if constexpr (Epi::PERM) epi.op8(brow + ai * HALF + wr_e * 64 + m * 16 + fr_e, bcol + bj * HALF + wc_e * 32 + fq_e * 8, acc[ai][bj][m][0], acc[ai][bj][m][1]);
                        else {
#pragma unroll
                            for (int n = 0; n < 2; ++n)
                                epi(brow + ai * HALF + wr_e * 64 + m * 16 + fr_e, bcol + bj * HALF + wc_e * 32 + n * 16 + fq_e * 4, acc[ai][bj][m][n]);
                        }
                    }
        }
        if (!has_next) break;
#pragma unroll
        for (int a_ = 0; a_ < 2; ++a_)
#pragma unroll
            for (int b_ = 0; b_ < 2; ++b_)
#pragma unroll
                for (int m = 0; m < 4; ++m)
#pragma unroll
                    for (int n = 0; n < 2; ++n) acc[a_][b_][m][n] = (f32x4){0.f, 0.f, 0.f, 0.f};
        tile = ntile; cpm = npm; cpn = npn; cA = nA; cB = nB;
        if (wr == 1) PG8_BAR;
    }
    PG8_WAIT_V(0);
    PG8_BAR;
#undef PG8_SA
#undef PG8_SB
#undef PG8_STAGE
#undef PG8_STAGEV
#undef PG8_LDA
#undef PG8_LDB
#undef PG8_MMA
#undef PG8_WAIT_V
#undef PG8_WAIT_L
#undef PG8_BAR
#undef PG8_SCHED
#undef PG8_TILE
}

struct EpiP0 { static constexpr bool PERM = true; static constexpr bool ROWSCALE = false; static constexpr bool ROWSS = false; bf16_t* prw; bf16_t* pret;
    __device__ __forceinline__ void op8(int row, int col, f32x4 v0, f32x4 v1) const {
        const u32x4 w = pk8(v0, v1);
        if (col < 1792) *(u32x4*)(prw + (size_t)row * 1792 + col) = w; else *(u32x4*)(pret + (size_t)row * 2048 + (col - 1792)) = w; } };
struct EpiLora { static constexpr bool PERM = true; static constexpr bool ROWSCALE = false; static constexpr bool ROWSS = false; bf16_t* base;
    __device__ __forceinline__ void op8(int row, int col, f32x4 v0, f32x4 v1) const {
        *(u32x4*)(base + (size_t)(col >> 9) * ((size_t)MTOK * 512) + (size_t)row * 512 + (col & 511)) = pk8(v0, v1); } };
__device__ __forceinline__ float sumsq8(const f32x4 a, const f32x4 b) { return ((a[0] * a[0] + a[1] * a[1]) + (a[2] * a[2] + a[3] * a[3])) + ((b[0] * b[0] + b[1] * b[1]) + (b[2] * b[2] + b[3] * b[3])); }
struct EpiResidIn { static constexpr bool PERM = true; static constexpr bool ROWSCALE = false; static constexpr bool ROWSS = true; const float* xin; bf16_t* xout; unsigned long long* r2;
    __device__ __forceinline__ float op8r(int row, int col, f32x4 v0, f32x4 v1) const {
        const float* xi = xin + (size_t)row * 1024 + col;
        const f32x4 x0 = *(const f32x4*)xi + v0, x1 = *(const f32x4*)(xi + 4) + v1; *(u32x4*)(xout + (size_t)row * 1024 + col) = pk8(x0, x1);
        return sumsq8(x0, x1); }
    __device__ __forceinline__ void rowdone(int row, float ss, int fq) const { ss += __shfl_xor(ss, 16); ss += __shfl_xor(ss, 32); if (fq == 0) atomicAdd(r2 + row, (unsigned long long)(ss * 1048576.0f + 0.5f)); } };
struct EpiResidN { static constexpr bool PERM = true; static constexpr bool ROWSCALE = false; static constexpr bool ROWSS = true; bf16_t* x; unsigned long long* r2;
    __device__ __forceinline__ float op8r(int row, int col, f32x4 v0, f32x4 v1) const {
        bf16_t* xp = x + (size_t)row * 1024 + col; const u32x4 r = *(const u32x4*)xp;
        f32x4 r0, r1; r0[0] = bflo(r[0]); r0[1] = bfhi(r[0]); r0[2] = bflo(r[1]); r0[3] = bfhi(r[1]); r1[0] = bflo(r[2]); r1[1] = bfhi(r[2]); r1[2] = bflo(r[3]); r1[3] = bfhi(r[3]);
        const f32x4 x0 = r0 + v0, x1 = r1 + v1; *(u32x4*)xp = pk8(x0, x1);
        return sumsq8(x0, x1); }
    __device__ __forceinline__ void rowdone(int row, float ss, int fq) const { ss += __shfl_xor(ss, 16); ss += __shfl_xor(ss, 32); if (fq == 0) atomicAdd(r2 + row, (unsigned long long)(ss * 1048576.0f + 0.5f)); } };
struct EpiResid { static constexpr bool PERM = true; static constexpr bool ROWSCALE = false; static constexpr bool ROWSS = false; bf16_t* x;
    __device__ __forceinline__ void op8(int row, int col, f32x4 v0, f32x4 v1) const {
        bf16_t* xp = x + (size_t)row * 1024 + col; const u32x4 r = *(const u32x4*)xp;
        f32x4 r0, r1; r0[0] = bflo(r[0]); r0[1] = bfhi(r[0]); r0[2] = bflo(r[1]); r0[3] = bfhi(r[1]); r1[0] = bflo(r[2]); r1[1] = bfhi(r[2]); r1[2] = bflo(r[3]); r1[3] = bfhi(r[3]);
        *(u32x4*)xp = pk8(r0 + v0, r1 + v1); } };
struct EpiRelu2 { static constexpr bool PERM = true; static constexpr bool ROWSS = false; static constexpr bool ROWSCALE = true; bf16_t* hid; const unsigned long long* r2;
    __device__ __forceinline__ float rowscale(int row) const { return __builtin_amdgcn_rcpf((float)r2[row] * (1.0f / (1024.0f * 1048576.0f)) + 1e-6f); }
    __device__ __forceinline__ void op8s(int row, int col, f32x4 v0, f32x4 v1, float rs2) const {
        f32x4 t0, t1; for (int i = 0; i < 4; ++i) { const float r0 = fmaxf(v0[i], 0.f), r1 = fmaxf(v1[i], 0.f); t0[i] = r0 * r0 * rs2; t1[i] = r1 * r1 * rs2; }
        *(u32x4*)(hid + (size_t)row * 4096 + col) = pk8(t0, t1); } };
struct EpiC { static constexpr bool PERM = true; static constexpr bool ROWSS = false; static constexpr bool ROWSCALE = true; bf16_t* pc; float* gates; const unsigned long long* r2;
    __device__ __forceinline__ float rowscale(int row) const { return rsqrtf((float)r2[row] * (1.0f / (1024.0f * 1048576.0f)) + 1e-6f); }
    __device__ __forceinline__ void op8s(int row, int col, f32x4 v0, f32x4 v1, float rs) const {
        v0 = v0 * rs; v1 = v1 * rs;
        if (col < 3072) *(u32x4*)(pc + (size_t)row * 3072 + col) = pk8(v0, v1);
        else if (col < 3088) { float* gp = gates + (size_t)row * 16 + (col - 3072); *(f32x4*)gp = v0; *(f32x4*)(gp + 4) = v1; } } };

__device__ __forceinline__ void transpose_job(const float* __restrict__ src, bf16_t* __restrict__ dst, const int K, const int N, const int Npad, const int wvs, const int bid, const int nb, const float* __restrict__ gk = nullptr) {
    float* tile = (float*)smem;
    const int nkt = K / 64, nnt = Npad / 64, tid = launder_tid(wvs);
    for (int t = bid; t < nkt * nnt; t += nb) {
        const int kt = t % nkt, ntl = t / nkt, k0 = kt * 64, n0 = ntl * 64;
        const int r = tid >> 4, c4 = (tid & 15) * 4;
#pragma unroll
        for (int p = 0; p < 2; ++p) { const int k = r + p * 32; f32x4 v = {0.f, 0.f, 0.f, 0.f};
            if (n0 + c4 < N) v = *(const f32x4*)(src + (size_t)(k0 + k) * N + n0 + c4);
            if (gk) v = v * gk[k0 + k];
            tile[k * 65 + c4 + 0] = v[0]; tile[k * 65 + c4 + 1] = v[1]; tile[k * 65 + c4 + 2] = v[2]; tile[k * 65 + c4 + 3] = v[3]; }
        __syncthreads();
        const int n = tid >> 3, k8 = (tid & 7) * 8;
        const float* s = tile + k8 * 65 + n;
        u32x4 o; o.x = pk2(s[0], s[65]); o.y = pk2(s[2 * 65], s[3 * 65]); o.z = pk2(s[4 * 65], s[5 * 65]); o.w = pk2(s[6 * 65], s[7 * 65]);
        *(u32x4*)(dst + (size_t)(n0 + n) * K + k0 + k8) = o;
        __syncthreads();
    }
}

__device__ __forceinline__ void norm_phase(const float* __restrict__ X, const float* __restrict__ g, bf16_t* __restrict__ Hout, float* __restrict__ Fout, const int wvs) {
    const int tid = launder_tid(wvs);
    const int wid = tid >> 6, lane = tid & 63;
    f32x4 gv[4];
#pragma unroll
    for (int j = 0; j < 4; ++j) gv[j] = *(const f32x4*)(g + lane * 4 + j * 256);
    for (int row = blockIdx.x * 8 + wid; row < MTOK; row += gridDim.x * 8) {
        const float* xr = X + (size_t)row * 1024 + lane * 4;
        f32x4 v[4]; float s = 0.f;
#pragma unroll
        for (int j = 0; j < 4; ++j) { v[j] = *(const f32x4*)(xr + j * 256); s += (v[j][0] * v[j][0] + v[j][1] * v[j][1]) + (v[j][2] * v[j][2] + v[j][3] * v[j][3]); }
        s = wave_sum(s);
        const float rs = rsqrtf(s * (1.0f / 1024.0f) + 1e-6f);
#pragma unroll
        for (int j = 0; j < 4; ++j) { const f32x4 o = v[j] * rs * gv[j];
            if (Hout) { u32x2 w; w.x = pk2(o[0], o[1]); w.y = pk2(o[2], o[3]); *(u32x2*)(Hout + (size_t)row * 1024 + lane * 4 + j * 256) = w; }
            else *(f32x4*)(Fout + (size_t)row * 1024 + lane * 4 + j * 256) = o; }
    }
}

__device__ __forceinline__ void norm_phase_b(const bf16_t* __restrict__ X, const float* __restrict__ g, bf16_t* __restrict__ Hout, float* __restrict__ Fout, const int wvs) {
    const int tid = launder_tid(wvs);
    const int wid = tid >> 6, lane = tid & 63;
    f32x4 gv[4];
#pragma unroll
    for (int j = 0; j < 2; ++j) { gv[2 * j] = *(const f32x4*)(g + lane * 8 + j * 512); gv[2 * j + 1] = *(const f32x4*)(g + lane * 8 + j * 512 + 4); }
    for (int row = blockIdx.x * 8 + wid; row < MTOK; row += gridDim.x * 8) {
        const bf16_t* xr = X + (size_t)row * 1024 + lane * 8;
        f32x4 v[4]; float s = 0.f;
#pragma unroll
        for (int j = 0; j < 2; ++j) { const u32x4 r = *(const u32x4*)(xr + j * 512);
            v[2 * j][0] = bflo(r[0]); v[2 * j][1] = bfhi(r[0]); v[2 * j][2] = bflo(r[1]); v[2 * j][3] = bfhi(r[1]);
            v[2 * j + 1][0] = bflo(r[2]); v[2 * j + 1][1] = bfhi(r[2]); v[2 * j + 1][2] = bflo(r[3]); v[2 * j + 1][3] = bfhi(r[3]); }
#pragma unroll
        for (int j = 0; j < 4; ++j) s += (v[j][0] * v[j][0] + v[j][1] * v[j][1]) + (v[j][2] * v[j][2] + v[j][3] * v[j][3]);
        s = wave_sum(s);
        const float rs = rsqrtf(s * (1.0f / 1024.0f) + 1e-6f);
#pragma unroll
        for (int j = 0; j < 2; ++j) { const f32x4 o0 = v[2 * j] * rs * gv[2 * j], o1 = v[2 * j + 1] * rs * gv[2 * j + 1];
            if (Hout) *(u32x4*)(Hout + (size_t)row * 1024 + lane * 8 + j * 512) = pk8(o0, o1);
            else { float* fo = Fout + (size_t)row * 1024 + lane * 8 + j * 512; *(f32x4*)fo = o0; *(f32x4*)(fo + 4) = o1; } }
    }
}

__device__ __forceinline__ void prologue_phase(KP p, const int wvs) {
    unsigned char* ws = p->ws;
    transpose_job(p->ab_w_in, (bf16_t*)(ws + WS_WT_AB), 1024, 3840, 3840, wvs, blockIdx.x, gridDim.x);
    const int gtid = blockIdx.x * 512 + launder_tid(wvs), gsz = gridDim.x * 512;
    bf16_t* wl = (bf16_t*)(ws + WS_WT_LORA);
    for (int idx = gtid; idx < 1536 * 256; idx += gsz) {
        const int n = idx >> 8, k = idx & 255; float v = 0.f;
        if (n < 512) { if (k < 64) v = p->rwkv_w_up[k * 512 + n]; }
        else if (n < 1024) { if (k >= 64 && k < 128) v = p->rwkv_a_up[(k - 64) * 512 + (n - 512)]; }
        else { if (k >= 128) v = p->rwkv_g_up[(k - 128) * 512 + (n - 1024)]; }
        wl[idx] = f2bf(v);
    }
    float* ct = (float*)(ws + WS_COS); float* stb = (float*)(ws + WS_SIN);
    for (int idx = gtid; idx < 4096 * 64; idx += gsz) {
        const int pos = idx >> 6, i = idx & 63;
        const float inv = powf(10000.0f, -(float)(2 * i) / 128.0f);
        const float ang = (float)pos * inv;
        double rev = (double)ang * 0.15915494309189535; rev -= __builtin_rint(rev);
        ct[idx] = __builtin_amdgcn_cosf((float)rev); stb[idx] = __builtin_amdgcn_sinf((float)rev);
    }
    { unsigned long long* r2 = (unsigned long long*)(ws + WS_R2); for (int idx = gtid; idx < 3 * MTOK; idx += gsz) r2[idx] = 0ull; }
    norm_phase(p->x, p->norm_mix_g, (bf16_t*)(ws + WS_H), nullptr, wvs);
}

__device__ __forceinline__ void lora_in_phase(KP p, const int wvs) {
    const bf16_t* prw = (const bf16_t*)(p->ws + WS_D_PRW); bf16_t* L = (bf16_t*)(p->ws + WS_D_L);
    const int gtid = blockIdx.x * 512 + launder_tid(wvs), gsz = gridDim.x * 512;
    for (int item = gtid; item < MTOK * 32; item += gsz) {
        const int row = item >> 5, c8 = (item & 31) * 8;
        const u32x4 cur = *(const u32x4*)(prw + (size_t)row * 1792 + 1536 + c8);
        u32x4 prv = {0u, 0u, 0u, 0u};
        if ((row & (SEQ - 1)) != 0) prv = *(const u32x4*)(prw + (size_t)(row - 1) * 1792 + 1536 + c8);
        const f32x4 m0 = *(const f32x4*)(p->rwkv_mu + 1536 + c8), m1 = *(const f32x4*)(p->rwkv_mu + 1536 + c8 + 4);
        float v[8];
#pragma unroll
        for (int i = 0; i < 4; ++i) {
            const float c0 = bflo(cur[i]), c1 = bfhi(cur[i]), p0 = bflo(prv[i]), p1 = bfhi(prv[i]);
            const float mu0 = (i < 2) ? m0[2 * i] : m1[2 * i - 4], mu1 = (i < 2) ? m0[2 * i + 1] : m1[2 * i - 3];
            v[2 * i] = c0 + (p0 - c0) * mu0; v[2 * i + 1] = c1 + (p1 - c1) * mu1;
        }
        if (c8 < 64) {
#pragma unroll
            for (int i = 0; i < 8; ++i) { const float e = __expf(2.f * v[i]); v[i] = 1.f - 2.f * __builtin_amdgcn_rcpf(e + 1.f); }
        } else if (c8 >= 128) {
#pragma unroll
            for (int i = 0; i < 8; ++i) v[i] = __builtin_amdgcn_rcpf(1.f + __expf(-v[i]));
        }
        u32x4 o; o.x = pk2(v[0], v[1]); o.y = pk2(v[2], v[3]); o.z = pk2(v[4], v[5]); o.w = pk2(v[6], v[7]);
        *(u32x4*)(L + (size_t)row * 256 + c8) = o;
    }
}

__device__ __forceinline__ void lds_barrier() { asm volatile("s_waitcnt lgkmcnt(0)" ::: "memory"); __builtin_amdgcn_s_barrier(); asm volatile("" ::: "memory"); }
typedef float f32x2 __attribute__((ext_vector_type(2)));
__device__ __forceinline__ void rwkv_scan_unit(KP p, const int unit, const int wvs) {
    const int b = unit >> 3, h = unit & 7;
    const int tid = launder_tid(wvs), wid = tid >> 6, lane = tid & 63;
    constexpr int TC = 16, NC = SEQ / TC;
    float* bufs = (float*)smem;
    float* yl = bufs + 2 * TC * 384;
    if (__builtin_amdgcn_readfirstlane(wid) < 4) {
        const int il = lane >> 3, jg = lane & 7, i0 = wid * 16 + il, i1 = i0 + 8;
        f32x2 A0 = {0.f, 0.f}, A1 = A0, A2 = A0, A3 = A0, B0 = A0, B1 = A0, B2 = A0, B3 = A0;
#define SC_LOAD(S, t_) do { const float* sn_ = sp + (t_) * 384; \
        a0##S = *(const f32x4*)(sn_); a1##S = *(const f32x4*)(sn_ + 4); w0##S = *(const f32x4*)(sn_ + 64); w1##S = *(const f32x4*)(sn_ + 68); \
        b0##S = *(const f32x4*)(sn_ + 128); b1##S = *(const f32x4*)(sn_ + 132); k0##S = *(const f32x4*)(sn_ + 192); k1##S = *(const f32x4*)(sn_ + 196); \
        r0##S = *(const f32x4*)(sn_ + 256); r1##S = *(const f32x4*)(sn_ + 260); v0##S = buf[(t_) * 384 + 320 + i0]; v1##S = buf[(t_) * 384 + 320 + i1]; } while (0)
#define SC_STEP(S, t_) do { \
        f32x2 ta = A0 * a0##S.xy; ta = A1 * a0##S.zw + ta; ta = A2 * a1##S.xy + ta; ta = A3 * a1##S.zw + ta; \
        f32x2 tb = B0 * a0##S.xy; tb = B1 * a0##S.zw + tb; tb = B2 * a1##S.xy + tb; tb = B3 * a1##S.zw + tb; \
        float sa = ta.x + ta.y, sb = tb.x + tb.y; sa = red8(sa); sb = red8(sb); \
        const f32x2 sa2 = {sa, sa}, sb2 = {sb, sb}, va2 = {v0##S, v0##S}, vb2 = {v1##S, v1##S}; \
        A0 = A0 * w0##S.xy + (sa2 * b0##S.xy + va2 * k0##S.xy); A1 = A1 * w0##S.zw + (sa2 * b0##S.zw + va2 * k0##S.zw); \
        A2 = A2 * w1##S.xy + (sa2 * b1##S.xy + va2 * k1##S.xy); A3 = A3 * w1##S.zw + (sa2 * b1##S.zw + va2 * k1##S.zw); \
        B0 = B0 * w0##S.xy + (sb2 * b0##S.xy + vb2 * k0##S.xy); B1 = B1 * w0##S.zw + (sb2 * b0##S.zw + vb2 * k0##S.zw); \
        B2 = B2 * w1##S.xy + (sb2 * b1##S.xy + vb2 * k1##S.xy); B3 = B3 * w1##S.zw + (sb2 * b1##S.zw + vb2 * k1##S.zw); \
        f32x2 ua = A0 * r0##S.xy; ua = A1 * r0##S.zw + ua; ua = A2 * r1##S.xy + ua; ua = A3 * r1##S.zw + ua; \
        f32x2 ub = B0 * r0##S.xy; ub = B1 * r0##S.zw + ub; ub = B2 * r1##S.xy + ub; ub = B3 * r1##S.zw + ub; \
        yb[(t_) * 512 + i0 * 8 + jg] = ua.x + ua.y; yb[(t_) * 512 + i1 * 8 + jg] = ub.x + ub.y; } while (0)
        lds_barrier();
        for (int c = 0; c < NC; ++c) {
            const float* buf = bufs + (c & 1) * (TC * 384);
            float* yb = yl + (c & 1) * (TC * 512);
            const float* sp = buf + jg * 8;
            f32x4 a0X, a1X, w0X, w1X, b0X, b1X, k0X, k1X, r0X, r1X, a0Y, a1Y, w0Y, w1Y, b0Y, b1Y, k0Y, k1Y, r0Y, r1Y; float v0X, v1X, v0Y, v1Y;
            SC_LOAD(X, 0);
#pragma unroll
            for (int t = 0; t < TC; t += 2) {
                SC_LOAD(Y, t + 1);
                SC_STEP(X, t);
                if (t + 2 < TC) SC_LOAD(X, t + 2);
                SC_STEP(Y, t + 1);
            }
            lds_barrier();
        }
        lds_barrier();
#undef SC_LOAD
#undef SC_STEP
    } else {
        const bf16_t* prw = (const bf16_t*)(p->ws + WS_D_PRW);
        const bf16_t* Wb = (const bf16_t*)(p->ws + WS_D_W);
        const bf16_t* AGb = (const bf16_t*)(p->ws + WS_D_AG);
        const bf16_t* Gb = (const bf16_t*)(p->ws + WS_D_G);
        bf16_t* YC = (bf16_t*)(p->ws + WS_H);
        const int ptid = tid - 256, st = ptid >> 4, sc = (ptid & 15) * 4, ch = h * 64 + sc;
        const f32x4 mu_r = *(const f32x4*)(p->rwkv_mu + ch), mu_k = *(const f32x4*)(p->rwkv_mu + 512 + ch), mu_v = *(const f32x4*)(p->rwkv_mu + 1024 + ch);
        const f32x4 kkc = *(const f32x4*)(p->rwkv_k_k + ch), kac = *(const f32x4*)(p->rwkv_k_a + ch), rkc = *(const f32x4*)(p->rwkv_r_k + ch);
        const f32x4 lnw = *(const f32x4*)(p->rwkv_ln_w + ch), lnb = *(const f32x4*)(p->rwkv_ln_b + ch);
        const f32x4 w0c = *(const f32x4*)(p->rwkv_w0 + ch), a0c = *(const f32x4*)(p->rwkv_a0 + ch);
        u32x2 r_c, r_p, k_c, k_p, v_c, v_p, w_r, ag_r, g_r;
#define RW_LOAD(c) do { const int t_ = (c) * TC + st; const size_t row_ = (size_t)b * SEQ + t_; const bf16_t* pr_ = prw + row_ * 1792 + ch; \
        r_c = *(const u32x2*)(pr_); k_c = *(const u32x2*)(pr_ + 512); v_c = *(const u32x2*)(pr_ + 1024); \
        if (t_ > 0) { r_p = *(const u32x2*)(pr_ - 1792); k_p = *(const u32x2*)(pr_ - 1792 + 512); v_p = *(const u32x2*)(pr_ - 1792 + 1024); } \
        else { r_p = (u32x2){0u, 0u}; k_p = r_p; v_p = r_p; } \
        w_r = *(const u32x2*)(Wb + row_ * 512 + ch); ag_r = *(const u32x2*)(AGb + row_ * 512 + ch); } while (0)
#define RW_WRITE(buf) do { float* d_ = (buf) + st * 384 + sc; \
        f32x4 rr_, kk_, vv_, ag_, ew_; \
        for (int e = 0; e < 2; ++e) { \
            { const float c0 = bflo(r_c[e]), c1 = bfhi(r_c[e]), p0 = bflo(r_p[e]), p1 = bfhi(r_p[e]); rr_[2 * e] = c0 + (p0 - c0) * mu_r[2 * e]; rr_[2 * e + 1] = c1 + (p1 - c1) * mu_r[2 * e + 1]; } \
            { const float c0 = bflo(k_c[e]), c1 = bfhi(k_c[e]), p0 = bflo(k_p[e]), p1 = bfhi(k_p[e]); kk_[2 * e] = c0 + (p0 - c0) * mu_k[2 * e]; kk_[2 * e + 1] = c1 + (p1 - c1) * mu_k[2 * e + 1]; } \
            { const float c0 = bflo(v_c[e]), c1 = bfhi(v_c[e]), p0 = bflo(v_p[e]), p1 = bfhi(v_p[e]); vv_[2 * e] = c0 + (p0 - c0) * mu_v[2 * e]; vv_[2 * e + 1] = c1 + (p1 - c1) * mu_v[2 * e + 1]; } \
            ag_[2 * e] = sigmoidf_(bflo(ag_r[e]) + a0c[2 * e]); ag_[2 * e + 1] = sigmoidf_(bfhi(ag_r[e]) + a0c[2 * e + 1]); \
            ew_[2 * e] = 0.60653066f * sigmoidf_(bflo(w_r[e]) + w0c[2 * e]); ew_[2 * e + 1] = 0.60653066f * sigmoidf_(bfhi(w_r[e]) + w0c[2 * e + 1]); } \
        const f32x4 kn_ = kk_ * kkc; float ss_ = (kn_[0] * kn_[0] + kn_[1] * kn_[1]) + (kn_[2] * kn_[2] + kn_[3] * kn_[3]); ss_ = red16(ss_); \
        const float rn_ = rsqrtf(fmaxf(ss_, 1e-24f)); const f32x4 kkn_ = kn_ * rn_; \
        f32x4 dec_; for (int e = 0; e < 4; ++e) dec_[e] = __expf(-ew_[e]); \
        *(f32x4*)(d_) = -kkn_; *(f32x4*)(d_ + 64) = dec_; *(f32x4*)(d_ + 128) = kkn_ * ag_; \
        *(f32x4*)(d_ + 192) = kk_ * (1.0f + (ag_ - 1.0f) * kac); *(f32x4*)(d_ + 256) = rr_; *(f32x4*)(d_ + 320) = vv_; } while (0)
#define RW_POST(c) do { const float* buf_ = bufs + ((c) & 1) * (TC * 384); const float* yp_ = yl + ((c) & 1) * (TC * 512) + st * 512 + sc * 8; \
            f32x4 y4; \
            for (int e = 0; e < 4; ++e) { const f32x4 q0 = *(const f32x4*)(yp_ + e * 8), q1 = *(const f32x4*)(yp_ + e * 8 + 4); y4[e] = ((q0[0] + q0[1]) + (q0[2] + q0[3])) + ((q1[0] + q1[1]) + (q1[2] + q1[3])); } \
            float s = (y4[0] + y4[1]) + (y4[2] + y4[3]); s = red16(s); \
            const float mean = s * (1.0f / 64.0f); const f32x4 d = y4 - mean; \
            float q = (d[0] * d[0] + d[1] * d[1]) + (d[2] * d[2] + d[3] * d[3]); q = red16(q); \
            const float rstd = rsqrtf(q * (1.0f / 64.0f) + 64e-5f); \
            const f32x4 rr = *(const f32x4*)(buf_ + st * 384 + 256 + sc), km = *(const f32x4*)(buf_ + st * 384 + 192 + sc), vv = *(const f32x4*)(buf_ + st * 384 + 320 + sc); \
            const f32x4 bt = rr * km * rkc; float bonus = (bt[0] + bt[1]) + (bt[2] + bt[3]); bonus = red16(bonus); \
            f32x4 gg; gg[0] = bflo(g_r[0]); gg[1] = bfhi(g_r[0]); gg[2] = bflo(g_r[1]); gg[3] = bfhi(g_r[1]); \
            const f32x4 o = ((d * rstd) * lnw + lnb + bonus * vv) * gg; \
            u32x2 w; w.x = pk2(o[0], o[1]); w.y = pk2(o[2], o[3]); \
            const size_t row_ = (size_t)b * SEQ + (c) * TC + st; \
            *(u32x2*)(YC + row_ * 1024 + ch) = w; } while (0)
#define RW_GLOAD(c) do { const size_t row_ = (size_t)b * SEQ + (c) * TC + st; g_r = *(const u32x2*)(Gb + row_ * 512 + ch); } while (0)
        RW_LOAD(0);
        RW_WRITE(bufs);
        RW_LOAD(1);
        lds_barrier();
        for (int c = 0; c < NC; ++c) {
            if (c >= 1) { RW_POST(c - 1); }
            RW_GLOAD(c);
            if (c + 1 < NC) RW_WRITE(bufs + ((c + 1) & 1) * (TC * 384));
            if (c + 2 < NC) RW_LOAD(c + 2);
            lds_barrier();
        }
        RW_POST(NC - 1);
        lds_barrier();
#undef RW_LOAD
#undef RW_WRITE
#undef RW_POST
#undef RW_GLOAD
    }
}

__device__ __forceinline__ int tsw(int row, int col) { return row * 72 + (col ^ (((row >> 3) & 7) << 3)); }
__device__ __forceinline__ bf16x8 pack_acc2(const f32x4 a, const f32x4 b) {
    const unsigned x0 = pk2(a[0], a[1]), x1 = pk2(a[2], a[3]), x2 = pk2(b[0], b[1]), x3 = pk2(b[2], b[3]);
    const u32x4 u = {x0, x1, x2, x3}; return __builtin_bit_cast(bf16x8, u);
}
__device__ __forceinline__ bf16x8 ld_2x4(const bf16_t* p0, const bf16_t* p1) {
    const u32x2 lo = *(const u32x2*)p0, hi = *(const u32x2*)p1; const u32x4 u = {lo[0], lo[1], hi[0], hi[1]}; return __builtin_bit_cast(bf16x8, u);
}

__device__ __forceinline__ void retention_unit(KP p, const int unit, const int wvs) {
    const int b = unit >> 2, h = unit & 3;
    const int tid = launder_tid(wvs), wid = tid >> 6, lane = tid & 63, fr = lane & 15, fq = lane >> 4, tb = wid & 3, eh = wid >> 2;
    bf16_t* Qs = (bf16_t*)smem;
    bf16_t* Ks = Qs + 64 * 136;
    bf16_t* Vt = Ks + 64 * 136;
    bf16_t* Kt = Vt + 128 * 72;
    bf16_t* STs = Kt + 128 * 72;
    float* red = (float*)(STs + 128 * 136);
    const bf16_t* pret = (const bf16_t*)(p->ws + WS_C);
    const float* cosT = (const float*)(p->ws + WS_COS); const float* sinT = (const float*)(p->ws + WS_SIN);
    bf16_t* YC = (bf16_t*)(p->ws + WS_H);
    const float lg2 = log2f(1.0f - exp2f(-5.0f - (float)h));
    const float cd = exp2f(lg2 * 64.0f);
    for (int i = tid; i < 128 * 136 / 2; i += 512) ((unsigned*)STs)[i] = 0u;
    f32x4 accST[8];
#pragma unroll
    for (int i = 0; i < 8; ++i) accST[i] = (f32x4){0.f, 0.f, 0.f, 0.f};
    u32x2 q1[2], q2[2], k1[2], k2[2]; f32x4 cs[2], sn[2]; u32x4 vr[2];
#define RT_LOAD(c) do { for (int pp = 0; pp < 2; ++pp) { const int item = tid + pp * 512, t_ = item >> 4, i4 = (item & 15) * 4, pos = (c) * 64 + t_; \
            const bf16_t* pr_ = pret + ((size_t)b * SEQ + pos) * 2048 + h * 128 + i4; \
            q1[pp] = *(const u32x2*)(pr_); q2[pp] = *(const u32x2*)(pr_ + 64); k1[pp] = *(const u32x2*)(pr_ + 512); k2[pp] = *(const u32x2*)(pr_ + 512 + 64); \
            cs[pp] = *(const f32x4*)(cosT + pos * 64 + i4); sn[pp] = *(const f32x4*)(sinT + pos * 64 + i4); \
            const int e8 = (item & 15) * 8; vr[pp] = *(const u32x4*)(pret + ((size_t)b * SEQ + pos) * 2048 + 1024 + h * 128 + e8); } } while (0)
#define RT_WRITE() do { for (int pp = 0; pp < 2; ++pp) { const int item = tid + pp * 512, t_ = item >> 4, i4 = (item & 15) * 4; \
            f32x4 a1_, a2_; a1_[0] = bflo(q1[pp][0]); a1_[1] = bfhi(q1[pp][0]); a1_[2] = bflo(q1[pp][1]); a1_[3] = bfhi(q1[pp][1]); \
            a2_[0] = bflo(q2[pp][0]); a2_[1] = bfhi(q2[pp][0]); a2_[2] = bflo(q2[pp][1]); a2_[3] = bfhi(q2[pp][1]); \
            f32x4 o1_ = a1_ * cs[pp] - a2_ * sn[pp], o2_ = a1_ * sn[pp] + a2_ * cs[pp]; \
            u32x2 w_; w_.x = pk2(o1_[0], o1_[1]); w_.y = pk2(o1_[2], o1_[3]); *(u32x2*)(Qs + t_ * 136 + i4) = w_; \
            w_.x = pk2(o2_[0], o2_[1]); w_.y = pk2(o2_[2], o2_[3]); *(u32x2*)(Qs + t_ * 136 + 64 + i4) = w_; \
            a1_[0] = bflo(k1[pp][0]); a1_[1] = bfhi(k1[pp][0]); a1_[2] = bflo(k1[pp][1]); a1_[3] = bfhi(k1[pp][1]); \
            a2_[0] = bflo(k2[pp][0]); a2_[1] = bfhi(k2[pp][0]); a2_[2] = bflo(k2[pp][1]); a2_[3] = bfhi(k2[pp][1]); \
            o1_ = (a1_ * cs[pp] - a2_ * sn[pp]) * 0.08838834764831845f; o2_ = (a1_ * sn[pp] + a2_ * cs[pp]) * 0.08838834764831845f; \
            w_.x = pk2(o1_[0], o1_[1]); w_.y = pk2(o1_[2], o1_[3]); *(u32x2*)(Ks + t_ * 136 + i4) = w_; \
            w_.x = pk2(o2_[0], o2_[1]); w_.y = pk2(o2_[2], o2_[3]); *(u32x2*)(Ks + t_ * 136 + 64 + i4) = w_; \
            const float kd_ = exp2f(lg2 * (float)(63 - t_)); \
            for (int e = 0; e < 4; ++e) { Kt[tsw(i4 + e, t_)] = f2bf(o1_[e] * kd_); Kt[tsw(64 + i4 + e, t_)] = f2bf(o2_[e] * kd_); } \
            const int e8 = (item & 15) * 8; \
            for (int e = 0; e < 4; ++e) { Vt[tsw(e8 + 2 * e, t_)] = (bf16_t)(vr[pp][e] & 0xffffu); Vt[tsw(e8 + 2 * e + 1, t_)] = (bf16_t)(vr[pp][e] >> 16); } } } while (0)
    RT_LOAD(0);
    RT_WRITE();
    lds_barrier();
    for (int c = 0; c < SEQ / 64; ++c) {
        if (c + 1 < SEQ / 64) RT_LOAD(c + 1);
        bf16x8 qf[4];
#pragma unroll
        for (int ks = 0; ks < 4; ++ks) qf[ks] = *(const bf16x8*)(Qs + (tb * 16 + fr) * 136 + ks * 32 + fq * 8);
        f32x4 sT[4];
#pragma unroll
        for (int s_ = 0; s_ < 4; ++s_) { sT[s_] = (f32x4){0.f, 0.f, 0.f, 0.f};
#pragma unroll
            for (int ks = 0; ks < 4; ++ks) { const bf16x8 kf = *(const bf16x8*)(Ks + (s_ * 16 + fr) * 136 + ks * 32 + fq * 8);
                sT[s_] = __builtin_amdgcn_mfma_f32_16x16x32_bf16(kf, qf[ks], sT[s_], 0, 0, 0); } }
        const int tl = tb * 16 + fr;
#pragma unroll
        for (int s_ = 0; s_ < 4; ++s_)
#pragma unroll
            for (int r = 0; r < 4; ++r) { const int sl = s_ * 16 + fq * 4 + r; sT[s_][r] = (sl <= tl) ? sT[s_][r] * exp2f(lg2 * (float)(tl - sl)) : 0.f; }
        f32x4 acc[4];
#pragma unroll
        for (int et = 0; et < 4; ++et) { acc[et] = (f32x4){0.f, 0.f, 0.f, 0.f};
#pragma unroll
            for (int ks = 0; ks < 4; ++ks) { const bf16x8 sf = *(const bf16x8*)(STs + ((eh * 4 + et) * 16 + fr) * 136 + ks * 32 + fq * 8);
                acc[et] = __builtin_amdgcn_mfma_f32_16x16x32_bf16(sf, qf[ks], acc[et], 0, 0, 0); } }
        const float qd = exp2f(lg2 * (float)(tl + 1));
#pragma unroll
        for (int et = 0; et < 4; ++et) acc[et] = acc[et] * qd;
#pragma unroll
        for (int k2_ = 0; k2_ < 2; ++k2_) { const bf16x8 bfr = pack_acc2(sT[2 * k2_], sT[2 * k2_ + 1]);
#pragma unroll
            for (int et = 0; et < 4; ++et) { const int vr_ = (eh * 4 + et) * 16 + fr;
                const bf16x8 af = ld_2x4(Vt + tsw(vr_, (2 * k2_) * 16 + fq * 4), Vt + tsw(vr_, (2 * k2_ + 1) * 16 + fq * 4));
                acc[et] = __builtin_amdgcn_mfma_f32_16x16x32_bf16(af, bfr, acc[et], 0, 0, 0); } }
        float ss = 0.f;
#pragma unroll
        for (int et = 0; et < 4; ++et) ss += (acc[et][0] * acc[et][0] + acc[et][1] * acc[et][1]) + (acc[et][2] * acc[et][2] + acc[et][3] * acc[et][3]);
        ss += __shfl_xor(ss, 16); ss += __shfl_xor(ss, 32);
        if (fq == 0) red[eh * 64 + tl] = ss;
#pragma unroll
        for (int dt = 0; dt < 8; ++dt) accST[dt] = accST[dt] * cd;
#pragma unroll
        for (int ks = 0; ks < 2; ++ks) { const bf16x8 af = *(const bf16x8*)(Vt + tsw(wid * 16 + fr, ks * 32 + fq * 8));
#pragma unroll
            for (int dt = 0; dt < 8; ++dt) { const bf16x8 bfr = *(const bf16x8*)(Kt + tsw(dt * 16 + fr, ks * 32 + fq * 8));
                accST[dt] = __builtin_amdgcn_mfma_f32_16x16x32_bf16(af, bfr, accST[dt], 0, 0, 0); } }
        lds_barrier();
        {
            const float tot = red[tl] + red[64 + tl];
            const float rn = rsqrtf(tot * (1.0f / 128.0f) + 1e-6f);
            const size_t row_ = (size_t)b * SEQ + c * 64 + tl;
#pragma unroll
            for (int et = 0; et < 4; ++et) { const int e0 = (eh * 4 + et) * 16 + fq * 4;
                const u32x2 gr = *(const u32x2*)(pret + row_ * 2048 + 1536 + h * 128 + e0);
                f32x4 g; g[0] = bflo(gr[0]); g[1] = bfhi(gr[0]); g[2] = bflo(gr[1]); g[3] = bfhi(gr[1]);
                f32x4 o; for (int r = 0; r < 4; ++r) o[r] = acc[et][r] * rn * (g[r] * sigmoidf_(g[r]));
                u32x2 w; w.x = pk2(o[0], o[1]); w.y = pk2(o[2], o[3]);
                *(u32x2*)(YC + row_ * 1024 + 512 + h * 128 + e0) = w; }
        }
#pragma unroll
        for (int dt = 0; dt < 8; ++dt)
#pragma unroll
            for (int r = 0; r < 4; ++r) STs[(wid * 16 + fq * 4 + r) * 136 + dt * 16 + fr] = f2bf(accST[dt][r]);
        if (c + 1 < SEQ / 64) RT_WRITE();
        lds_barrier();
    }
#undef RT_LOAD
#undef RT_WRITE
}

__device__ __forceinline__ float softcapf(float x) { const float e = __expf(2.f * x * (1.0f / 15.0f)); return 15.0f * (1.f - 2.f / (e + 1.f)); }

__device__ __forceinline__ void mlstm_unit(KP p, const int unit, const int wvs) {
    const int par = unit & 1, bh = unit >> 1, b = bh >> 3, h = bh & 7;
    const int tid = launder_tid(wvs), wid = tid >> 6, lane = tid & 63, fr = lane & 15, fq = lane >> 4, tb = wid & 3, eh = wid >> 2;
    bf16_t* Qs = (bf16_t*)smem;
    bf16_t* Ks = Qs + 64 * 72;
    bf16_t* Vt = Ks + 64 * 72;
    bf16_t* Kt = Vt + 144 * 72;
    bf16_t* CTs = Kt + 64 * 72;
    float* red = (float*)(CTs + 144 * 72);
    float* cwl = red + 128;
    float* nwl = cwl + 640;
    float* Gs = nwl + 128;
    float* Mx = Gs + 64 * 68;
    float* Ee = Mx + 64 * 68;
    const bf16_t* pc = (const bf16_t*)(p->ws + WS_D);
    const float* gates = (const float*)(p->ws + WS_GATES);
    bf16_t* YC = (bf16_t*)(p->ws + WS_H);
    for (int i = tid; i < 144 * 72 / 2; i += 512) ((unsigned*)CTs)[i] = 0u;
    for (int i = tid; i < 16 * 72 / 2; i += 512) ((unsigned*)(Vt + 128 * 72))[i] = (i < 36) ? 0x3F803F80u : 0u;
    for (int i = tid; i < 640; i += 512) { const int j = i >> 7, cc = i & 127; const int col = (cc >> 6) * 512 + h * 64 + (cc & 63);
        cwl[i] = (j < 4) ? p->c_conv_w[j * 1024 + col] : p->c_conv_b[col]; }
    if (tid < 128) nwl[tid] = p->c_norm_w[h * 128 + tid];
    if (wid == 0) {
        const float ibias = p->c_i_bias[h], fbias = p->c_f_bias[h];
        const float* gr = gates + ((size_t)b * SEQ + lane * 64) * 16 + h;
        float bsum = 0.f;
        for (int i = 0; i < 64; ++i) { const float li = softcapf(gr[i * 16] + ibias), lf = -log1pf(__expf(-softcapf(gr[i * 16 + 8] + fbias)));
            bsum += lf; Gs[lane * 68 + i] = li; Ee[lane * 68 + i] = lf; }
        float inc = bsum;
        for (int o = 1; o < 64; o <<= 1) { const float n_ = __shfl_up(inc, o); if (lane >= o) inc += n_; }
        float Bc = inc - bsum, lmax = -3.0e38f;
        for (int i = 0; i < 64; ++i) { Bc += Ee[lane * 68 + i]; const float g = Gs[lane * 68 + i] - Bc; Gs[lane * 68 + i] = g; Ee[lane * 68 + i] = Bc; lmax = fmaxf(lmax, g); }
        float pm = lmax;
        for (int o = 1; o < 64; o <<= 1) { const float n_ = __shfl_up(pm, o); if (lane >= o) pm = fmaxf(pm, n_); }
        float run = __shfl_up(pm, 1); if (lane == 0) run = 0.f; run = fmaxf(run, 0.f);
        for (int i = 0; i < 64; ++i) { run = fmaxf(run, Gs[lane * 68 + i]); Mx[lane * 68 + i] = run; Ee[lane * 68 + i] += run; }
    }
    f32x4 accC[4], accCa;
#pragma unroll
    for (int i = 0; i < 4; ++i) accC[i] = (f32x4){0.f, 0.f, 0.f, 0.f};
    accCa = (f32x4){0.f, 0.f, 0.f, 0.f};
    const int gidx = tid & 15, isK = gidx >> 3, c8 = (gidx & 7) * 8, ccol = isK * 512 + h * 64 + c8, lcol = isK * 64 + c8;
    const int tK = tid >> 3, c8K = (tid & 7) * 8, ccolK = 512 + h * 64 + c8K, lcolK = 64 + c8K;
    u32x4 xr[2][4]; u32x4 vr[2]; u32x2 og[4];
#define ML_LDX(dst, t_, pos_, col_) do { const bf16_t* pr_ = pc + ((size_t)b * SEQ + (pos_)) * 3072; \
        for (int j = 0; j < 4; ++j) { if ((pos_) - 3 + j >= 0) dst[j] = *(const u32x4*)(pr_ + (long)(j - 3) * 3072 + (col_)); else dst[j] = (u32x4){0u, 0u, 0u, 0u}; } } while (0)
#define ML_LOAD(c) do { if ((((c) & 1) == par)) { for (int pp = 0; pp < 2; ++pp) { const int t_ = (tid + pp * 512) >> 4; ML_LDX(xr[pp], t_, (c) * 64 + t_, ccol); } } \
        else { ML_LDX(xr[0], tK, (c) * 64 + tK, ccolK); } \
        for (int pp = 0; pp < 2; ++pp) { const int item = tid + pp * 512, t_ = item >> 4, e8 = (item & 15) * 8; \
            vr[pp] = *(const u32x4*)(pc + ((size_t)b * SEQ + (c) * 64 + t_) * 3072 + 1024 + h * 128 + e8); } } while (0)
#define ML_CONV(src, lcol_, y_) do { \
            { const f32x4 b0_ = *(const f32x4*)(cwl + 512 + (lcol_)), b1_ = *(const f32x4*)(cwl + 512 + (lcol_) + 4); \
              y_[0] = b0_[0]; y_[1] = b0_[1]; y_[2] = b0_[2]; y_[3] = b0_[3]; y_[4] = b1_[0]; y_[5] = b1_[1]; y_[6] = b1_[2]; y_[7] = b1_[3]; } \
            for (int j = 0; j < 4; ++j) { const f32x4 w0_ = *(const f32x4*)(cwl + j * 128 + (lcol_)), w1_ = *(const f32x4*)(cwl + j * 128 + (lcol_) + 4); \
                y_[0] += w0_[0] * bflo(src[j][0]); y_[1] += w0_[1] * bfhi(src[j][0]); y_[2] += w0_[2] * bflo(src[j][1]); y_[3] += w0_[3] * bfhi(src[j][1]); \
                y_[4] += w1_[0] * bflo(src[j][2]); y_[5] += w1_[1] * bfhi(src[j][2]); y_[6] += w1_[2] * bflo(src[j][3]); y_[7] += w1_[3] * bfhi(src[j][3]); } \
            for (int e = 0; e < 8; ++e) y_[e] = y_[e] * sigmoid_fast(y_[e]); } while (0)
#define ML_KOUT(y_, t_, c8_) do { for (int e = 0; e < 8; ++e) y_[e] *= 0.125f; \
                u32x4 o_; o_.x = pk2(y_[0], y_[1]); o_.y = pk2(y_[2], y_[3]); o_.z = pk2(y_[4], y_[5]); o_.w = pk2(y_[6], y_[7]); *(u32x4*)(Ks + (t_) * 72 + (c8_)) = o_; \
                const float kw_ = __expf(ga_[(t_)] - M63_); for (int e = 0; e < 8; ++e) Kt[tsw((c8_) + e, (t_))] = f2bf(y_[e] * kw_); } while (0)
#define ML_WRITE(c) do { const float* ga_ = Gs + (c) * 68; const float M63_ = Mx[(c) * 68 + 63]; \
        if ((((c) & 1) == par)) { for (int pp = 0; pp < 2; ++pp) { const int t_ = (tid + pp * 512) >> 4; float y_[8]; ML_CONV(xr[pp], lcol, y_); \
                if (isK == 0) { u32x4 o_; o_.x = pk2(y_[0], y_[1]); o_.y = pk2(y_[2], y_[3]); o_.z = pk2(y_[4], y_[5]); o_.w = pk2(y_[6], y_[7]); *(u32x4*)(Qs + t_ * 72 + c8) = o_; } \
                else ML_KOUT(y_, t_, c8); } } \
        else { float y_[8]; ML_CONV(xr[0], lcolK, y_); ML_KOUT(y_, tK, c8K); } \
        for (int pp = 0; pp < 2; ++pp) { const int item = tid + pp * 512, t_ = item >> 4, e8 = (item & 15) * 8; \
            for (int e = 0; e < 4; ++e) { Vt[tsw(e8 + 2 * e, t_)] = (bf16_t)(vr[pp][e] & 0xffffu); Vt[tsw(e8 + 2 * e + 1, t_)] = (bf16_t)(vr[pp][e] >> 16); } } } while (0)
    ML_LOAD(0);
    lds_barrier();
    ML_WRITE(0);
    lds_barrier();
    for (int c = 0; c < SEQ / 64; ++c) {
        const float* ga = Gs + c * 68;
        const bool own = ((c & 1) == par);
        if (c + 1 < SEQ / 64) ML_LOAD(c + 1);
        const int tl = tb * 16 + fr;
        const float M63 = Mx[c * 68 + 63];
        const float Mprev = (c == 0) ? 0.f : Mx[(c - 1) * 68 + 63];
        f32x4 acc[5];
        if (own) {
            {
                const size_t row_ = (size_t)b * SEQ + c * 64 + tl;
#pragma unroll
                for (int et = 0; et < 4; ++et) og[et] = *(const u32x2*)(pc + row_ * 3072 + 2048 + h * 128 + (eh * 4 + et) * 16 + fq * 4);
            }
            bf16x8 qf[2];
#pragma unroll
            for (int ks = 0; ks < 2; ++ks) qf[ks] = *(const bf16x8*)(Qs + tl * 72 + ks * 32 + fq * 8);
            f32x4 sT[4];
#pragma unroll
            for (int s_ = 0; s_ < 4; ++s_) { sT[s_] = (f32x4){0.f, 0.f, 0.f, 0.f};
#pragma unroll
                for (int ks = 0; ks < 2; ++ks) { const bf16x8 kf = *(const bf16x8*)(Ks + (s_ * 16 + fr) * 72 + ks * 32 + fq * 8);
                    sT[s_] = __builtin_amdgcn_mfma_f32_16x16x32_bf16(kf, qf[ks], sT[s_], 0, 0, 0); } }
            const float Mt = Mx[c * 68 + tl], Et = Ee[c * 68 + tl];
#pragma unroll
            for (int s_ = 0; s_ < 4; ++s_) { const f32x4 g4 = *(const f32x4*)(ga + s_ * 16 + fq * 4);
#pragma unroll
                for (int r = 0; r < 4; ++r) { const int sl = s_ * 16 + fq * 4 + r; sT[s_][r] = (sl <= tl) ? sT[s_][r] * __expf(g4[r] - Mt) : 0.f; } }
#pragma unroll
            for (int et = 0; et < 5; ++et) { acc[et] = (f32x4){0.f, 0.f, 0.f, 0.f}; const int etile = (et < 4) ? (eh * 4 + et) : 8;
#pragma unroll
                for (int ks = 0; ks < 2; ++ks) { const bf16x8 cf = *(const bf16x8*)(CTs + (etile * 16 + fr) * 72 + ks * 32 + fq * 8);
                    acc[et] = __builtin_amdgcn_mfma_f32_16x16x32_bf16(cf, qf[ks], acc[et], 0, 0, 0); } }
            const float inter = __expf(Mprev - Mt);
#pragma unroll
            for (int et = 0; et < 5; ++et) acc[et] = acc[et] * inter;
#pragma unroll
            for (int k2_ = 0; k2_ < 2; ++k2_) { const bf16x8 bfr = pack_acc2(sT[2 * k2_], sT[2 * k2_ + 1]);
#pragma unroll
                for (int et = 0; et < 5; ++et) { const int etile = (et < 4) ? (eh * 4 + et) : 8; const int vr_ = etile * 16 + fr;
                    const bf16x8 af = ld_2x4(Vt + tsw(vr_, (2 * k2_) * 16 + fq * 4), Vt + tsw(vr_, (2 * k2_ + 1) * 16 + fq * 4));
                    acc[et] = __builtin_amdgcn_mfma_f32_16x16x32_bf16(af, bfr, acc[et], 0, 0, 0); } }
            const float den = __shfl(acc[4][0], fr);
            const float dn = 1.0f / fmaxf(fabsf(den), __expf(-Et));
            float ss = 0.f;
#pragma unroll
            for (int et = 0; et < 4; ++et) { acc[et] = acc[et] * dn; ss += (acc[et][0] * acc[et][0] + acc[et][1] * acc[et][1]) + (acc[et][2] * acc[et][2] + acc[et][3] * acc[et][3]); }
            ss += __shfl_xor(ss, 16); ss += __shfl_xor(ss, 32);
            if (fq == 0) red[eh * 64 + tl] = ss;
        }
        const float csc = __expf(Mprev - M63);
#pragma unroll
        for (int dt = 0; dt < 4; ++dt) accC[dt] = accC[dt] * csc;
        accCa = accCa * csc;
#pragma unroll
        for (int ks = 0; ks < 2; ++ks) { const bf16x8 af = *(const bf16x8*)(Vt + tsw(wid * 16 + fr, ks * 32 + fq * 8));
#pragma unroll
            for (int dt = 0; dt < 4; ++dt) { const bf16x8 bfr = *(const bf16x8*)(Kt + tsw(dt * 16 + fr, ks * 32 + fq * 8));
                accC[dt] = __builtin_amdgcn_mfma_f32_16x16x32_bf16(af, bfr, accC[dt], 0, 0, 0); }
            if (wid < 4) { const bf16x8 aa = *(const bf16x8*)(Vt + tsw(128 + fr, ks * 32 + fq * 8)), bb = *(const bf16x8*)(Kt + tsw(wid * 16 + fr, ks * 32 + fq * 8));
                accCa = __builtin_amdgcn_mfma_f32_16x16x32_bf16(aa, bb, accCa, 0, 0, 0); } }
        lds_barrier();
        if (own) {
            const float tot = red[tl] + red[64 + tl];
            const float rn = rsqrtf(tot * (1.0f / 128.0f) + 1e-6f);
            const size_t row_ = (size_t)b * SEQ + c * 64 + tl;
#pragma unroll
            for (int et = 0; et < 4; ++et) { const int e0 = (eh * 4 + et) * 16 + fq * 4;
                const f32x4 nw = *(const f32x4*)(nwl + e0);
                f32x4 ogf; ogf[0] = bflo(og[et][0]); ogf[1] = bfhi(og[et][0]); ogf[2] = bflo(og[et][1]); ogf[3] = bfhi(og[et][1]);
                f32x4 o; for (int r = 0; r < 4; ++r) o[r] = acc[et][r] * rn * nw[r] * sigmoid_fast(ogf[r]);
                u32x2 w; w.x = pk2(o[0], o[1]); w.y = pk2(o[2], o[3]);
                *(u32x2*)(YC + row_ * 1024 + h * 128 + e0) = w; }
        }
        if (!own) {
#pragma unroll
            for (int dt = 0; dt < 4; ++dt)
#pragma unroll
                for (int r = 0; r < 4; ++r) CTs[(wid * 16 + fq * 4 + r) * 72 + dt * 16 + fr] = f2bf(accC[dt][r]);
            if (wid < 4) {
#pragma unroll
                for (int r = 0; r < 4; ++r) CTs[(128 + fq * 4 + r) * 72 + wid * 16 + fr] = f2bf(accCa[r]);
            }
        }
        if (c + 1 < SEQ / 64) ML_WRITE(c + 1);
        lds_barrier();
    }
#undef ML_LDX
#undef ML_LOAD
#undef ML_CONV
#undef ML_KOUT
#undef ML_WRITE
}

__device__ __forceinline__ void late_weights(KP p, const int wvs, const int bid, const int nb) {
    unsigned char* ws = p->ws;
    transpose_job(p->ab_w_out, (bf16_t*)(ws + WS_WT_ABO), 1024, 1024, 1024, wvs, bid, nb);
    transpose_job(p->mlp_w1, (bf16_t*)(ws + WS_WT_W1_0), 1024, 4096, 4096, wvs, bid, nb, p->norm_mlp_g);
    transpose_job(p->mlp_w2, (bf16_t*)(ws + WS_WT_W2_0), 4096, 1024, 1024, wvs, bid, nb);
    transpose_job(p->c_w_in, (bf16_t*)(ws + WS_WT_C), 1024, 3088, 3328, wvs, bid, nb, p->norm_mix_g + 1024);
    transpose_job(p->c_w_out, (bf16_t*)(ws + WS_WT_CO), 1024, 1024, 1024, wvs, bid, nb);
    transpose_job(p->mlp_w1 + (size_t)1024 * 4096, (bf16_t*)(ws + WS_WT_W1_1), 1024, 4096, 4096, wvs, bid, nb, p->norm_mlp_g + 1024);
    transpose_job(p->mlp_w2 + (size_t)1024 * 4096, (bf16_t*)(ws + WS_WT_W2_1), 4096, 1024, 1024, wvs, bid, nb);
}

#define XB_TMO      128
#define XB_XCNT(j)  (256  + 64 * (j))
#define XB_XSUB(j)  (1280 + 64 * (j))
#define XB_XGEN(j)  (2304 + 64 * (j))
#define XB_TOP      3328
#define XB_TOPGEN   3392
#define XB_SPIN_CAP (1u << 18)
typedef __attribute__((address_space(3))) unsigned lds_uword;
__device__ __forceinline__ unsigned xb_ld(unsigned* p)              { return __hip_atomic_load(p, __ATOMIC_RELAXED, __HIP_MEMORY_SCOPE_AGENT); }
__device__ __forceinline__ unsigned xb_add(unsigned* p, unsigned v) { return __hip_atomic_fetch_add(p, v, __ATOMIC_RELAXED, __HIP_MEMORY_SCOPE_AGENT); }
__device__ __forceinline__ unsigned xb_xcc_id() { return (unsigned)__builtin_amdgcn_s_getreg((3 << 11) | 20) & 0xFu; }
#define XB_SPIN(cond, bar) do { unsigned _sp = 0; while (cond) { __builtin_amdgcn_s_sleep(1); \
    if ((++_sp & 255u) == 0u) { if (xb_ld(&(bar)[XB_TMO])) break; if (_sp > XB_SPIN_CAP) { atomicAdd(&(bar)[XB_TMO], 1u); break; } } } } while (0)
struct XcdBarrier { unsigned* bar; unsigned x; volatile lds_uword* st; };
__device__ __forceinline__ void xcd_barrier_complete(unsigned* bar, unsigned x, unsigned& nloc, unsigned& nx) {
    const unsigned G = gridDim.x;
    unsigned sum, cnt, mine, sp = 0u;
    for (;;) {
        sum = 0u; cnt = 0u; mine = 0u;
#pragma unroll
        for (unsigned j = 0; j < 16; ++j) { const unsigned c = xb_ld(&bar[XB_XCNT(j)]); sum += c; cnt += (c > 0u) ? 1u : 0u; mine = (j == x) ? c : mine; }
        if (sum == G) break;
        __builtin_amdgcn_s_sleep(1);
        if ((++sp & 255u) == 0u) { if (xb_ld(&bar[XB_TMO])) break; if (sp > XB_SPIN_CAP) { atomicAdd(&bar[XB_TMO], 1u); break; } }
    }
    nloc = mine > 0u ? mine : 1u; nx = cnt > 0u ? cnt : 1u;
}
__device__ __forceinline__ void xcd_barrier(const XcdBarrier& b, const int wvs) {
    asm volatile("s_waitcnt vmcnt(0)" ::: "memory");
    __syncthreads();
    if (launder_tid(wvs) == 0) {
        unsigned* bar = b.bar;
        __builtin_amdgcn_s_waitcnt(0);
        unsigned nloc = b.st[0], nx = b.st[1];
        if (nloc == 0u) { xcd_barrier_complete(bar, b.x, nloc, nx); b.st[0] = nloc; b.st[1] = nx; }
        const unsigned old = xb_add(&bar[XB_XSUB(b.x)], 1u);
        const unsigned gen = old / nloc;
        if (old + 1u == (gen + 1u) * nloc) {
            __builtin_amdgcn_fence(__ATOMIC_RELEASE, "agent");
            asm volatile("s_waitcnt vmcnt(0)" ::: "memory");
            const unsigned og = xb_add(&bar[XB_TOP], 1u);
            const unsigned tg = og / nx;
            if (og + 1u == (tg + 1u) * nx) xb_add(&bar[XB_TOPGEN], 1u);
            else XB_SPIN(xb_ld(&bar[XB_TOPGEN]) == tg, bar);
            __builtin_amdgcn_fence(__ATOMIC_ACQUIRE, "agent");
            xb_add(&bar[XB_XGEN(b.x)], 1u);
            asm volatile("s_waitcnt vmcnt(0)" ::: "memory");
        } else {
            XB_SPIN(xb_ld(&bar[XB_XGEN(b.x)]) == gen, bar);
            __builtin_amdgcn_fence(__ATOMIC_ACQUIRE, "agent");
            asm volatile("s_waitcnt vmcnt(0)" ::: "memory");
        }
    }
    __syncthreads();
}

__global__ void __launch_bounds__(512) fwd_megakernel(const Params p_unused) {
    cg::grid_group grid = cg::this_grid();
    const KP kp0 = (KP)__builtin_amdgcn_kernarg_segment_ptr();
    const int wvs = __builtin_amdgcn_readfirstlane((int)(threadIdx.x >> 6));
    XcdBarrier xbar; xbar.bar = (unsigned*)(launder(kp0)->ws + WS_BAR); xbar.x = xb_xcc_id(); xbar.st = (volatile lds_uword*)(smem + GEMM_LDS);
    if (launder_tid(wvs) == 0) { xbar.st[0] = 0u; xbar.st[1] = 0u; (void)xb_add(&xbar.bar[XB_XCNT(xbar.x)], 1u); }
#define WSP (launder(kp0)->ws)
    prologue_phase(launder(kp0), wvs);
    grid.sync();
    { unsigned char* ws = WSP; gemm_phase<3840, 1024>((const bf16_t*)(ws + WS_H), (const bf16_t*)(ws + WS_WT_AB), EpiP0{(bf16_t*)(ws + WS_D_PRW), (bf16_t*)(ws + WS_C)}, wvs); }
    xcd_barrier(xbar, wvs);
    lora_in_phase(launder(kp0), wvs);
    xcd_barrier(xbar, wvs);
    { KP p = launder(kp0); unsigned char* ws = p->ws; gemm_phase<1536, 256>((const bf16_t*)(ws + WS_D_L), (const bf16_t*)(ws + WS_WT_LORA),
               EpiLora{(bf16_t*)(ws + WS_D_W)}, wvs); }
    xcd_barrier(xbar, wvs);
    if (blockIdx.x < 128) rwkv_scan_unit(launder(kp0), blockIdx.x, wvs);
    else if (blockIdx.x < 192) retention_unit(launder(kp0), blockIdx.x - 128, wvs);
    else if (blockIdx.x < 256) late_weights(launder(kp0), wvs, blockIdx.x - 192, 64);
    xcd_barrier(xbar, wvs);
    { KP p = launder(kp0); unsigned char* ws = p->ws; gemm_phase<1024, 1024>((const bf16_t*)(ws + WS_H), (const bf16_t*)(ws + WS_WT_ABO), EpiResidIn{p->x, (bf16_t*)(ws + WS_C), (unsigned long long*)(ws + WS_R2)}, wvs); }
    xcd_barrier(xbar, wvs);
    { unsigned char* ws = WSP; gemm_phase<4096, 1024>((const bf16_t*)(ws + WS_C), (const bf16_t*)(ws + WS_WT_W1_0), EpiRelu2{(bf16_t*)(ws + WS_D), (const unsigned long long*)(ws + WS_R2)}, wvs); }
    xcd_barrier(xbar, wvs);
    { unsigned char* ws = WSP; gemm_phase<1024, 4096>((const bf16_t*)(ws + WS_D), (const bf16_t*)(ws + WS_WT_W2_0), EpiResidN{(bf16_t*)(ws + WS_C), (unsigned long long*)(ws + WS_R2) + MTOK}, wvs); }
    xcd_barrier(xbar, wvs);
    { unsigned char* ws = WSP; gemm_phase<3328, 1024, EpiC, true>((const bf16_t*)(ws + WS_C), (const bf16_t*)(ws + WS_WT_C), EpiC{(bf16_t*)(ws + WS_D), (float*)(ws + WS_GATES), (const unsigned long long*)(ws + WS_R2) + MTOK}, wvs); }
    xcd_barrier(xbar, wvs);
    if (blockIdx.x < 256) mlstm_unit(launder(kp0), blockIdx.x, wvs);
    xcd_barrier(xbar, wvs);
    { unsigned char* ws = WSP; gemm_phase<1024, 1024>((const bf16_t*)(ws + WS_H), (const bf16_t*)(ws + WS_WT_CO), EpiResidN{(bf16_t*)(ws + WS_C), (unsigned long long*)(ws + WS_R2) + 2 * MTOK}, wvs); }
    xcd_barrier(xbar, wvs);
    { unsigned char* ws = WSP; gemm_phase<4096, 1024>((const bf16_t*)(ws + WS_C), (const bf16_t*)(ws + WS_WT_W1_1), EpiRelu2{(bf16_t*)(ws + WS_D), (const unsigned long long*)(ws + WS_R2) + 2 * MTOK}, wvs); }
    xcd_barrier(xbar, wvs);
    { unsigned char* ws = WSP; gemm_phase<1024, 4096>((const bf16_t*)(ws + WS_D), (const bf16_t*)(ws + WS_WT_W2_1), EpiResid{(bf16_t*)(ws + WS_C)}, wvs); }
    xcd_barrier(xbar, wvs);
    { KP p = launder(kp0); unsigned char* ws = p->ws; norm_phase_b((const bf16_t*)(ws + WS_C), p->norm_final_g, nullptr, p->out, wvs); }
#undef WSP
}

extern "C" void kernel_launch(void* const* d_in, const int* in_sizes, int n_in, void* d_out, int out_size, void* d_ws, size_t ws_size, hipStream_t stream) {
    constexpr int LDS_BYTES = GEMM_LDS + 64 + 1024;
    static int grid_blocks = 0;
    if (!grid_blocks) {
        int dev = 0, cus = 0, per_cu = 0;
        hipGetDevice(&dev);
        hipDeviceGetAttribute(&cus, hipDeviceAttributeMultiprocessorCount, dev);
        hipFuncSetAttribute((const void*)fwd_megakernel, hipFuncAttributeMaxDynamicSharedMemorySize, LDS_BYTES);
        hipOccupancyMaxActiveBlocksPerMultiprocessor(&per_cu, (const void*)fwd_megakernel, 512, LDS_BYTES);
        if (per_cu < 1) per_cu = 1;
        grid_blocks = cus;
        if (grid_blocks != 256) fprintf(stderr, "kernel_launch: expected 256 CUs, got %d\n", grid_blocks);
    }
    (void)hipMemsetAsync((unsigned char*)d_ws + WS_BAR, 0, WS_BAR_BYTES, stream);
    Params hp{};
    const float** pp = (const float**)&hp;
    for (int i = 0; i < 26; ++i) pp[i] = (const float*)d_in[i];
    hp.out = (float*)d_out; hp.ws = (unsigned char*)d_ws;
    void* args[] = {&hp};
    hipError_t e = hipLaunchCooperativeKernel((const void*)fwd_megakernel, dim3(grid_blocks), dim3(512), args, LDS_BYTES, stream);
    if (e != hipSuccess) fprintf(stderr, "cooperative launch failed: %s (grid %d)\n", hipGetErrorString(e), grid_blocks);
}
```

```cpp
#include <hip/hip_runtime.h>
#include <hip/hip_cooperative_groups.h>
#include <cstdint>
#include <cstdio>
namespace cg = cooperative_groups;

typedef unsigned short bf16_t;
typedef short bf16x8 __attribute__((ext_vector_type(8)));
typedef float f32x4 __attribute__((ext_vector_type(4)));
typedef unsigned u32x4 __attribute__((ext_vector_type(4)));
typedef unsigned u32x2 __attribute__((ext_vector_type(2)));

constexpr int MTOK = 65536, SEQ = 4096;
constexpr size_t MB = 1024 * 1024;
constexpr size_t WS_WT_AB = 0;
constexpr size_t WS_WT_ABO = WS_WT_AB + 3840 * 1024 * 2;
constexpr size_t WS_WT_W1_0 = WS_WT_ABO + 1024 * 1024 * 2;
constexpr size_t WS_WT_W2_0 = WS_WT_W1_0 + 4096 * 1024 * 2;
constexpr size_t WS_WT_C = WS_WT_W2_0 + 4096 * 1024 * 2;
constexpr size_t WS_WT_CO = WS_WT_C + 3328 * 1024 * 2;
constexpr size_t WS_WT_W1_1 = WS_WT_CO + 1024 * 1024 * 2;
constexpr size_t WS_WT_W2_1 = WS_WT_W1_1 + 4096 * 1024 * 2;
constexpr size_t WS_WT_LORA = WS_WT_W2_1 + 4096 * 1024 * 2;
constexpr size_t WS_COS = WS_WT_LORA + 1536 * 256 * 2;
constexpr size_t WS_SIN = WS_COS + 4096 * 64 * 4;
constexpr size_t WS_GATES = WS_SIN + 4096 * 64 * 4;
constexpr size_t WS_BAR = WS_GATES + (size_t)MTOK * 16 * 4;
constexpr size_t WS_BAR_BYTES = 16384;
constexpr size_t WS_R2 = WS_BAR + WS_BAR_BYTES;
constexpr size_t WS_A_END = WS_R2 + (size_t)3 * MTOK * 8;
static_assert(WS_A_END <= 60 * MB, "region A");
constexpr size_t WS_H = 60 * MB;
constexpr size_t WS_C = 188 * MB;
constexpr size_t WS_D = 444 * MB;
constexpr size_t WS_D_PRW = WS_D;
constexpr size_t WS_D_W = WS_D_PRW + (size_t)MTOK * 1792 * 2;
constexpr size_t WS_D_AG = WS_D_W + (size_t)MTOK * 512 * 2;
constexpr size_t WS_D_G = WS_D_AG + (size_t)MTOK * 512 * 2;
constexpr size_t WS_D_L = WS_D_G + (size_t)MTOK * 512 * 2;
static_assert(WS_D_L + (size_t)MTOK * 256 * 2 <= WS_D + 512 * MB, "region D");

struct Params {
    const float* x; const float* norm_mix_g; const float* norm_mlp_g; const float* norm_final_g;
    const float* ab_w_in; const float* rwkv_mu; const float* rwkv_w0; const float* rwkv_w_up; const float* rwkv_a0; const float* rwkv_a_up;
    const float* rwkv_g_up; const float* rwkv_k_k; const float* rwkv_k_a; const float* rwkv_r_k; const float* rwkv_ln_w; const float* rwkv_ln_b;
    const float* ab_w_out; const float* c_w_in; const float* c_conv_w; const float* c_conv_b; const float* c_i_bias; const float* c_f_bias;
    const float* c_norm_w; const float* c_w_out; const float* mlp_w1; const float* mlp_w2;
    float* out; unsigned char* ws;
};

typedef const Params __attribute__((address_space(4)))* KP;
__device__ __forceinline__ KP launder(KP p) { asm volatile("" : "+s"(p)); return p; }
__device__ __forceinline__ int launder_tid(const int wvs) { int l; asm volatile("v_mbcnt_lo_u32_b32 %0, -1, 0\n\tv_mbcnt_hi_u32_b32 %0, -1, %0" : "=v"(l)); return wvs * 64 + l; }
extern __shared__ __attribute__((aligned(16))) unsigned char smem[];

__device__ __forceinline__ unsigned pk2(float lo, float hi) { unsigned r; asm("v_cvt_pk_bf16_f32 %0, %1, %2" : "=v"(r) : "v"(lo), "v"(hi)); return r; }
__device__ __forceinline__ u32x4 pk8(const f32x4 a, const f32x4 b) { u32x4 w; w.x = pk2(a[0], a[1]); w.y = pk2(a[2], a[3]); w.z = pk2(b[0], b[1]); w.w = pk2(b[2], b[3]); return w; }
__device__ __forceinline__ bf16_t f2bf(float f) { return (bf16_t)(pk2(f, 0.f) & 0xffffu); }
__device__ __forceinline__ float bflo(unsigned u) { return __uint_as_float(u << 16); }
__device__ __forceinline__ float bfhi(unsigned u) { return __uint_as_float(u & 0xffff0000u); }
__device__ __forceinline__ float sigmoidf_(float z) { return 1.f / (1.f + __expf(-z)); }
__device__ __forceinline__ float sigmoid_fast(float z) { return __builtin_amdgcn_rcpf(1.f + __expf(-z)); }
template <int CTRL> __device__ __forceinline__ float dpp_add(float v) {
    return v + __builtin_bit_cast(float, __builtin_amdgcn_update_dpp(0, __builtin_bit_cast(int, v), CTRL, 0xf, 0xf, false));
}
__device__ __forceinline__ float red8(float v) { v = dpp_add<0xB1>(v); v = dpp_add<0x4E>(v); v = dpp_add<0x141>(v); return v; }
__device__ __forceinline__ float red16(float v) { v += __shfl_xor(v, 1); v += __shfl_xor(v, 2); v += __shfl_xor(v, 4); v += __shfl_xor(v, 8); return v; }
__device__ __forceinline__ float wave_sum(float v) { v = red16(v); v += __shfl_xor(v, 16); v += __shfl_xor(v, 32); return v; }

constexpr int BM = 256, BK = 64, HALF = 128, HT = HALF * BK, GEMM_LDS = 8 * HT * 2;
__device__ __forceinline__ int lds_byte(int r, int c) { int st = (r >> 4) * 2 + (c >> 5), rr = r & 15, cc = c & 31, ob = rr * 64 + cc * 2; return st * 1024 + (ob ^ (((ob >> 9) & 1) << 5)); }
__device__ __forceinline__ void stage_rc(int b, int& R, int& C) { int st = b / 1024, sb = b % 1024, swz = sb ^ (((sb >> 9) & 1) << 5); R = (st >> 1) * 16 + swz / 64; C = (st & 1) * 32 + (swz % 64) / 2; }

template <int N, int K, class Epi, int LD = K, bool KSEL = false>
__device__ __forceinline__ void gemm_phase(const bf16_t* __restrict__ A, const bf16_t* __restrict__ Bt, const Epi epi, const int wvs) {
    typedef __attribute__((address_space(3))) unsigned char lds_u8;
    typedef __attribute__((address_space(3))) unsigned lds_u32;
    typedef __attribute__((address_space(3))) bf16x8 lds_bf16x8;
    lds_u8* lds = (lds_u8*)smem;
    constexpr int HTB = HALF * BK * 2;
    constexpr int nN = N / BM, ntiles = (MTOK / BM) * nN, nt = K / BK;
    const int tid = launder_tid(wvs), wid = wvs, lane = tid & 63, wr = wid >> 2, wc = wid & 3, fr = lane & 15, fq = lane >> 4;
    unsigned voff[2], voffB[2];
#pragma unroll
    for (int i = 0; i < 2; ++i) { int R, C; stage_rc(tid * 16 + i * 8192, R, C); voff[i] = (unsigned)(R * LD + C) * 2u;
        const int rho = R & 31, Rb = Epi::PERM ? ((R & ~31) + 8 * ((rho & 15) >> 2) + 4 * (rho >> 4) + (rho & 3)) : R; voffB[i] = (unsigned)(Rb * LD + C) * 2u; }
    constexpr size_t kstep = (size_t)(BK * 2), hstep = (size_t)HALF * LD * 2, tstep = 2 * hstep;
    const unsigned ldsw = (unsigned)wid * 1024u;
    const int aoff = lds_byte(wr * 64 + fr, fq * 8), boff = lds_byte(wc * 32 + fr, fq * 8);
#define PG8_SA(b, h) (((b) * 2 + (h)) * HTB)
#define PG8_SB(b, h) ((4 + (b) * 2 + (h)) * HTB)
#define PG8_STAGE(bufoff, gbase) PG8_STAGEV(bufoff, gbase, voff)
#define PG8_STAGEV(bufoff, gbase, vo_) do { _Pragma("unroll") for (int _i = 0; _i < 2; ++_i) \
        __builtin_amdgcn_global_load_lds((const unsigned*)((const char*)(gbase) + vo_[_i]), (lds_u32*)(lds + (bufoff) + ldsw + _i * 8192), 16, 0, 0); } while (0)
#define PG8_LDA(dst, b, h) do { _Pragma("unroll") for (int m = 0; m < 4; ++m) _Pragma("unroll") for (int k = 0; k < 2; ++k) dst[m][k] = *(const lds_bf16x8*)(lds + PG8_SA(b, h) + aoff + m * 2048 + k * 1024); } while (0)
#define PG8_LDB(dst, b, h) do { _Pragma("unroll") for (int n = 0; n < 2; ++n) _Pragma("unroll") for (int k = 0; k < 2; ++k) dst[n][k] = *(const lds_bf16x8*)(lds + PG8_SB(b, h) + boff + n * 2048 + k * 1024); } while (0)
#define PG8_MMA(ai, bj, At, Bt_) do { __builtin_amdgcn_s_setprio(1); _Pragma("unroll") for (int m = 0; m < 4; ++m) _Pragma("unroll") for (int n = 0; n < 2; ++n) _Pragma("unroll") for (int k = 0; k < 2; ++k) \
        acc[ai][bj][m][n] = __builtin_amdgcn_mfma_f32_16x16x32_bf16(Bt_[n][k], At[m][k], acc[ai][bj][m][n], 0, 0, 0); __builtin_amdgcn_s_setprio(0); } while (0)
#define PG8_WAIT_V(n) asm volatile("s_waitcnt vmcnt(" #n ")" ::: "memory")
#define PG8_WAIT_L(n) asm volatile("s_waitcnt lgkmcnt(" #n ")" ::: "memory")
#define PG8_BAR __builtin_amdgcn_s_barrier()
#define PG8_SCHED __builtin_amdgcn_sched_barrier(0)
#define PG8_TILE(t_, pm_, pn_) do { const int w_ = ((t_) & 7) * (ntiles / 8) + ((t_) >> 3); const int g_ = w_ / (8 * nN), r_ = w_ - g_ * (8 * nN); pm_ = g_ * 8 + (r_ & 7); pn_ = r_ >> 3; } while (0)
    int tile = blockIdx.x;
    if (tile >= ntiles) return;
    int cpm, cpn; PG8_TILE(tile, cpm, cpn);
    f32x4 acc[2][2][4][2];
#pragma unroll
    for (int a_ = 0; a_ < 2; ++a_)
#pragma unroll
        for (int b_ = 0; b_ < 2; ++b_)
#pragma unroll
            for (int m = 0; m < 4; ++m)
#pragma unroll
                for (int n = 0; n < 2; ++n) acc[a_][b_][m][n] = (f32x4){0.f, 0.f, 0.f, 0.f};
    bf16x8 At[4][2], B0[2][2], B1[2][2];
    const char* cA = (const char*)A + (size_t)cpm * tstep + (KSEL && cpn >= 4 ? 256 : 0); const char* cB = (const char*)Bt + (size_t)cpn * tstep + (KSEL && cpn >= 4 ? 256 : 0);
    PG8_STAGEV(PG8_SB(0, 0), cB, voffB); PG8_STAGEV(PG8_SB(0, 1), cB + hstep, voffB); PG8_STAGE(PG8_SA(0, 0), cA); PG8_STAGE(PG8_SA(0, 1), cA + hstep);
    if (wr == 1) PG8_BAR;
    PG8_WAIT_V(2); PG8_BAR;
    PG8_STAGEV(PG8_SB(1, 0), cB + kstep, voffB); PG8_STAGE(PG8_SA(1, 0), cA + kstep); PG8_STAGEV(PG8_SB(1, 1), cB + hstep + kstep, voffB);
    PG8_WAIT_V(6); PG8_BAR;
    for (;;) {
        const int ntile = tile + gridDim.x; const bool has_next = ntile < ntiles;
        int npm = cpm, npn = cpn; if (has_next) PG8_TILE(ntile, npm, npn);
        const char* nA = (const char*)A + (size_t)npm * tstep + (KSEL && npn >= 4 ? 256 : 0); const char* nB = (const char*)Bt + (size_t)npn * tstep + (KSEL && npn >= 4 ? 256 : 0);
        for (int t = 0; t < nt; t += 2) {
            const bool last = (t == nt - 2);
            const char* a1 = cA + (size_t)(t + 1) * kstep;
            const char* a2 = last ? nA : cA + (size_t)(t + 2) * kstep; const char* b2 = last ? nB : cB + (size_t)(t + 2) * kstep;
            const char* a3 = a2 + kstep; const char* b3 = b2 + kstep;
            PG8_LDB(B0, 0, 0); PG8_LDB(B1, 0, 1); PG8_SCHED; PG8_LDA(At, 0, 0); PG8_STAGE(PG8_SA(1, 1), a1 + hstep);
            PG8_WAIT_V(8); PG8_WAIT_L(0); PG8_BAR; PG8_MMA(0, 0, At, B0); PG8_MMA(0, 1, At, B1); PG8_BAR; PG8_SCHED;
            PG8_LDA(At, 0, 1); PG8_STAGEV(PG8_SB(0, 0), b2, voffB); PG8_STAGEV(PG8_SB(0, 1), b2 + hstep, voffB); PG8_STAGE(PG8_SA(0, 0), a2);
            PG8_WAIT_V(8); PG8_WAIT_L(0); PG8_BAR; PG8_MMA(1, 0, At, B0); PG8_MMA(1, 1, At, B1); PG8_BAR; PG8_SCHED;
            PG8_LDB(B0, 1, 0); PG8_LDB(B1, 1, 1); PG8_SCHED; PG8_LDA(At, 1, 0); PG8_STAGE(PG8_SA(0, 1), a2 + hstep);
            PG8_WAIT_V(8); PG8_WAIT_L(0); PG8_BAR; PG8_MMA(0, 0, At, B0); PG8_MMA(0, 1, At, B1); PG8_BAR; PG8_SCHED;
            PG8_LDA(At, 1, 1); PG8_STAGEV(PG8_SB(1, 0), b3, voffB); PG8_STAGEV(PG8_SB(1, 1), b3 + hstep, voffB); PG8_STAGE(PG8_SA(1, 0), a3);
            PG8_WAIT_V(8); PG8_WAIT_L(0); PG8_BAR; PG8_MMA(1, 0, At, B0); PG8_MMA(1, 1, At, B1); PG8_BAR; PG8_SCHED;
        }
        if (wr == 0) PG8_BAR;
        {
            const int tid_e = launder_tid(wvs), wr_e = (tid_e >> 8) & 1, wc_e = (tid_e >> 6) & 3, fr_e = tid_e & 15, fq_e = (tid_e >> 4) & 3;
            const int brow = cpm * BM, bcol = cpn * BM; float rowss = 0.f; (void)rowss;
            volatile __attribute__((address_space(3))) float* rsL = (volatile __attribute__((address_space(3))) float*)(lds + GEMM_LDS + 64);
            if constexpr (Epi::ROWSCALE) {
                if (tid_e < 256) rsL[tid_e] = epi.rowscale(brow + tid_e);
                PG8_WAIT_L(0); PG8_BAR; asm volatile("" ::: "memory");
            }
#pragma unroll
            for (int ai = 0; ai < 2; ++ai)
#pragma unroll
                for (int m = 0; m < 4; ++m)
#pragma unroll
                    for (int bj = 0; bj < 2; ++bj) {
                        if constexpr (Epi::ROWSCALE) epi.op8s(brow + ai * HALF + wr_e * 64 + m * 16 + fr_e, bcol + bj * HALF + wc_e * 32 + fq_e * 8, acc[ai][bj][m][0], acc[ai][bj][m][1], rsL[ai * HALF + wr_e * 64 + m * 16 + fr_e]);
                        else if constexpr (Epi::ROWSS) { const float ss_ = epi.op8r(brow + ai * HALF + wr_e * 64 + m * 16 + fr_e, bcol + bj * HALF + wc_e * 32 + fq_e * 8, acc[ai][bj][m][0], acc[ai][bj][m][1]);
                            if (bj == 0) rowss = ss_; else epi.rowdone(brow + ai * HALF + wr_e * 64 + m * 16 + fr_e, rowss + ss_, fq_e); }
                        else if constexpr (Epi::PERM) epi.op8(brow + ai * HALF + wr_e * 64 + m * 16 + fr_e, bcol + bj * HALF + wc_e * 32 + fq_e * 8, acc[ai][bj][m][0], acc[ai][bj][m][1]);
                        else {
#pragma unroll
                            for (int n = 0; n < 2; ++n)
                                epi(brow + ai * HALF + wr_e * 64 + m * 16 + fr_e, bcol + bj * HALF + wc_e * 32 + n * 16 + fq_e * 4, acc[ai][bj][m][n]);
                        }
                    }
        }
        if (!has_next) break;
#pragma unroll
        for (int a_ = 0; a_ < 2; ++a_)
#pragma unroll
            for (int b_ = 0; b_ < 2; ++b_)
#pragma unroll
                for (int m = 0; m < 4; ++m)
#pragma unroll
                    for (int n = 0; n < 2; ++n) acc[a_][b_][m][n] = (f32x4){0.f, 0.f, 0.f, 0.f};
        tile = ntile; cpm = npm; cpn = npn; cA = nA; cB = nB;
        if (wr == 1) PG8_BAR;
    }
    PG8_WAIT_V(0);
    PG8_BAR;
#undef PG8_SA
#undef PG8_SB
#undef PG8_STAGE
#undef PG8_STAGEV
#undef PG8_LDA
#undef PG8_LDB
#undef PG8_MMA
#undef PG8_WAIT_V
#undef PG8_WAIT_L
#undef PG8_BAR
#undef PG8_SCHED
#undef PG8_TILE
}

struct EpiP0 { static constexpr bool PERM = true; static constexpr bool ROWSCALE = false; static constexpr bool ROWSS = false; bf16_t* prw; bf16_t* pret;
    __device__ __forceinline__ void op8(int row, int col, f32x4 v0, f32x4 v1) const {
        const u32x4 w = pk8(v0, v1);
        if (col < 1792) __builtin_nontemporal_store(w, (u32x4*)(prw + (size_t)row * 1792 + col)); else __builtin_nontemporal_store(w, (u32x4*)(pret + (size_t)row * 2048 + (col - 1792))); } };
struct EpiLora { static constexpr bool PERM = true; static constexpr bool ROWSCALE = false; static constexpr bool ROWSS = false; bf16_t* base;
    __device__ __forceinline__ void op8(int row, int col, f32x4 v0, f32x4 v1) const {
        *(u32x4*)(base + (size_t)(col >> 9) * ((size_t)MTOK * 512) + (size_t)row * 512 + (col & 511)) = pk8(v0, v1); } };
__device__ __forceinline__ float sumsq8(const f32x4 a, const f32x4 b) { return ((a[0] * a[0] + a[1] * a[1]) + (a[2] * a[2] + a[3] * a[3])) + ((b[0] * b[0] + b[1] * b[1]) + (b[2] * b[2] + b[3] * b[3])); }
struct EpiResidIn { static constexpr bool PERM = true; static constexpr bool ROWSCALE = false; static constexpr bool ROWSS = true; const float* xin; bf16_t* xout; unsigned long long* r2;
    __device__ __forceinline__ float op8r(int row, int col, f32x4 v0, f32x4 v1) const {
        const float* xi = xin + (size_t)row * 1024 + col;
        const f32x4 x0 = *(const f32x4*)xi + v0, x1 = *(const f32x4*)(xi + 4) + v1; *(u32x4*)(xout + (size_t)row * 1024 + col) = pk8(x0, x1);
        return sumsq8(x0, x1); }
    __device__ __forceinline__ void rowdone(int row, float ss, int fq) const { ss += __shfl_xor(ss, 16); ss += __shfl_xor(ss, 32); if (fq == 0) atomicAdd(r2 + row, (unsigned long long)(ss * 1048576.0f + 0.5f)); } };
struct EpiResidN { static constexpr bool PERM = true; static constexpr bool ROWSCALE = false; static constexpr bool ROWSS = true; bf16_t* x; unsigned long long* r2;
    __device__ __forceinline__ float op8r(int row, int col, f32x4 v0, f32x4 v1) const {
        bf16_t* xp = x + (size_t)row * 1024 + col; const u32x4 r = *(const u32x4*)xp;
        f32x4 r0, r1; r0[0] = bflo(r[0]); r0[1] = bfhi(r[0]); r0[2] = bflo(r[1]); r0[3] = bfhi(r[1]); r1[0] = bflo(r[2]); r1[1] = bfhi(r[2]); r1[2] = bflo(r[3]); r1[3] = bfhi(r[3]);
        const f32x4 x0 = r0 + v0, x1 = r1 + v1; *(u32x4*)xp = pk8(x0, x1);
        return sumsq8(x0, x1); }
    __device__ __forceinline__ void rowdone(int row, float ss, int fq) const { ss += __shfl_xor(ss, 16); ss += __shfl_xor(ss, 32); if (fq == 0) atomicAdd(r2 + row, (unsigned long long)(ss * 1048576.0f + 0.5f)); } };
struct EpiResid { static constexpr bool PERM = true; static constexpr bool ROWSCALE = false; static constexpr bool ROWSS = false; bf16_t* x;
    __device__ __forceinline__ void op8(int row, int col, f32x4 v0, f32x4 v1) const {
        bf16_t* xp = x + (size_t)row * 1024 + col; const u32x4 r = *(const u32x4*)xp;
        f32x4 r0, r1; r0[0] = bflo(r[0]); r0[1] = bfhi(r[0]); r0[2] = bflo(r[1]); r0[3] = bfhi(r[1]); r1[0] = bflo(r[2]); r1[1] = bfhi(r[2]); r1[2] = bflo(r[3]); r1[3] = bfhi(r[3]);
        *(u32x4*)xp = pk8(r0 + v0, r1 + v1); } };
struct EpiRelu2 { static constexpr bool PERM = true; static constexpr bool ROWSS = false; static constexpr bool ROWSCALE = true; bf16_t* hid; const unsigned long long* r2;
    __device__ __forceinline__ float rowscale(int row) const { return __builtin_amdgcn_rcpf((float)r2[row] * (1.0f / (1024.0f * 1048576.0f)) + 1e-6f); }
    __device__ __forceinline__ void op8s(int row, int col, f32x4 v0, f32x4 v1, float rs2) const {
        f32x4 t0, t1; for (int i = 0; i < 4; ++i) { const float r0 = fmaxf(v0[i], 0.f), r1 = fmaxf(v1[i], 0.f); t0[i] = r0 * r0 * rs2; t1[i] = r1 * r1 * rs2; }
        __builtin_nontemporal_store(pk8(t0, t1), (u32x4*)(hid + (size_t)row * 4096 + col)); } };
struct EpiC { static constexpr bool PERM = true; static constexpr bool ROWSS = false; static constexpr bool ROWSCALE = true; bf16_t* pc; float* gates; const unsigned long long* r2;
    __device__ __forceinline__ float rowscale(int row) const { return rsqrtf((float)r2[row] * (1.0f / (1024.0f * 1048576.0f)) + 1e-6f); }
    __device__ __forceinline__ void op8s(int row, int col, f32x4 v0, f32x4 v1, float rs) const {
        v0 = v0 * rs; v1 = v1 * rs;
        if (col < 3072) __builtin_nontemporal_store(pk8(v0, v1), (u32x4*)(pc + (size_t)row * 3072 + col));
        else if (col < 3088) { float* gp = gates + (size_t)row * 16 + (col - 3072); *(f32x4*)gp = v0; *(f32x4*)(gp + 4) = v1; } } };

__device__ __forceinline__ void transpose_job(const float* __restrict__ src, bf16_t* __restrict__ dst, const int K, const int N, const int Npad, const int wvs, const int bid, const int nb, const float* __restrict__ gk = nullptr) {
    float* tile = (float*)smem;
    const int nkt = K / 64, nnt = Npad / 64, tid = launder_tid(wvs);
    for (int t = bid; t < nkt * nnt; t += nb) {
        const int kt = t % nkt, ntl = t / nkt, k0 = kt * 64, n0 = ntl * 64;
        const int r = tid >> 4, c4 = (tid & 15) * 4;
#pragma unroll
        for (int p = 0; p < 2; ++p) { const int k = r + p * 32; f32x4 v = {0.f, 0.f, 0.f, 0.f};
            if (n0 + c4 < N) v = *(const f32x4*)(src + (size_t)(k0 + k) * N + n0 + c4);
            if (gk) v = v * gk[k0 + k];
            tile[k * 65 + c4 + 0] = v[0]; tile[k * 65 + c4 + 1] = v[1]; tile[k * 65 + c4 + 2] = v[2]; tile[k * 65 + c4 + 3] = v[3]; }
        __syncthreads();
        const int n = tid >> 3, k8 = (tid & 7) * 8;
        const float* s = tile + k8 * 65 + n;
        u32x4 o; o.x = pk2(s[0], s[65]); o.y = pk2(s[2 * 65], s[3 * 65]); o.z = pk2(s[4 * 65], s[5 * 65]); o.w = pk2(s[6 * 65], s[7 * 65]);
        *(u32x4*)(dst + (size_t)(n0 + n) * K + k0 + k8) = o;
        __syncthreads();
    }
}

__device__ __forceinline__ void norm_phase(const float* __restrict__ X, const float* __restrict__ g, bf16_t* __restrict__ Hout, float* __restrict__ Fout, const int wvs) {
    const int tid = launder_tid(wvs);
    const int wid = tid >> 6, lane = tid & 63;
    f32x4 gv[4];
#pragma unroll
    for (int j = 0; j < 4; ++j) gv[j] = *(const f32x4*)(g + lane * 4 + j * 256);
    for (int row = blockIdx.x * 8 + wid; row < MTOK; row += gridDim.x * 8) {
        const float* xr = X + (size_t)row * 1024 + lane * 4;
        f32x4 v[4]; float s = 0.f;
#pragma unroll
        for (int j = 0; j < 4; ++j) { v[j] = *(const f32x4*)(xr + j * 256); s += (v[j][0] * v[j][0] + v[j][1] * v[j][1]) + (v[j][2] * v[j][2] + v[j][3] * v[j][3]); }
        s = wave_sum(s);
        const float rs = rsqrtf(s * (1.0f / 1024.0f) + 1e-6f);
#pragma unroll
        for (int j = 0; j < 4; ++j) { const f32x4 o = v[j] * rs * gv[j];
            if (Hout) { u32x2 w; w.x = pk2(o[0], o[1]); w.y = pk2(o[2], o[3]); *(u32x2*)(Hout + (size_t)row * 1024 + lane * 4 + j * 256) = w; }
            else *(f32x4*)(Fout + (size_t)row * 1024 + lane * 4 + j * 256) = o; }
    }
}

__device__ __forceinline__ void norm_phase_b(const bf16_t* __restrict__ X, const float* __restrict__ g, bf16_t* __restrict__ Hout, float* __restrict__ Fout, const int wvs) {
    const int tid = launder_tid(wvs);
    const int wid = tid >> 6, lane = tid & 63;
    f32x4 gv[4];
#pragma unroll
    for (int j = 0; j < 2; ++j) { gv[2 * j] = *(const f32x4*)(g + lane * 8 + j * 512); gv[2 * j + 1] = *(const f32x4*)(g + lane * 8 + j * 512 + 4); }
    for (int row = blockIdx.x * 8 + wid; row < MTOK; row += gridDim.x * 8) {
        const bf16_t* xr = X + (size_t)row * 1024 + lane * 8;
        f32x4 v[4]; float s = 0.f;
#pragma unroll
        for (int j = 0; j < 2; ++j) { const u32x4 r = *(const u32x4*)(xr + j * 512);
            v[2 * j][0] = bflo(r[0]); v[2 * j][1] = bfhi(r[0]); v[2 * j][2] = bflo(r[1]); v[2 * j][3] = bfhi(r[1]);
            v[2 * j + 1][0] = bflo(r[2]); v[2 * j + 1][1] = bfhi(r[2]); v[2 * j + 1][2] = bflo(r[3]); v[2 * j + 1][3] = bfhi(r[3]); }
#pragma unroll
        for (int j = 0; j < 4; ++j) s += (v[j][0] * v[j][0] + v[j][1] * v[j][1]) + (v[j][2] * v[j][2] + v[j][3] * v[j][3]);
        s = wave_sum(s);
        const float rs = rsqrtf(s * (1.0f / 1024.0f) + 1e-6f);
#pragma unroll
        for (int j = 0; j < 2; ++j) { const f32x4 o0 = v[2 * j] * rs * gv[2 * j], o1 = v[2 * j + 1] * rs * gv[2 * j + 1];
            if (Hout) *(u32x4*)(Hout + (size_t)row * 1024 + lane * 8 + j * 512) = pk8(o0, o1);
            else { float* fo = Fout + (size_t)row * 1024 + lane * 8 + j * 512; *(f32x4*)fo = o0; *(f32x4*)(fo + 4) = o1; } }
    }
}

__device__ __forceinline__ void prologue_phase(KP p, const int wvs) {
    unsigned char* ws = p->ws;
    transpose_job(p->ab_w_in, (bf16_t*)(ws + WS_WT_AB), 1024, 3840, 3840, wvs, blockIdx.x, gridDim.x);
    const int gtid = blockIdx.x * 512 + launder_tid(wvs), gsz = gridDim.x * 512;
    bf16_t* wl = (bf16_t*)(ws + WS_WT_LORA);
    for (int idx = gtid; idx < 1536 * 256; idx += gsz) {
        const int n = idx >> 8, k = idx & 255; float v = 0.f;
        if (n < 512) { if (k < 64) v = p->rwkv_w_up[k * 512 + n]; }
        else if (n < 1024) { if (k >= 64 && k < 128) v = p->rwkv_a_up[(k - 64) * 512 + (n - 512)]; }
        else { if (k >= 128) v = p->rwkv_g_up[(k - 128) * 512 + (n - 1024)]; }
        wl[idx] = f2bf(v);
    }
    float* ct = (float*)(ws + WS_COS); float* stb = (float*)(ws + WS_SIN);
    for (int idx = gtid; idx < 4096 * 64; idx += gsz) {
        const int pos = idx >> 6, i = idx & 63;
        const float inv = powf(10000.0f, -(float)(2 * i) / 128.0f);
        const float ang = (float)pos * inv;
        double rev = (double)ang * 0.15915494309189535; rev -= __builtin_rint(rev);
        ct[idx] = __builtin_amdgcn_cosf((float)rev); stb[idx] = __builtin_amdgcn_sinf((float)rev);
    }
    { unsigned long long* r2 = (unsigned long long*)(ws + WS_R2); for (int idx = gtid; idx < 3 * MTOK; idx += gsz) r2[idx] = 0ull; }
    norm_phase(p->x, p->norm_mix_g, (bf16_t*)(ws + WS_H), nullptr, wvs);
}

__device__ __forceinline__ void lora_in_phase(KP p, const int wvs) {
    const bf16_t* prw = (const bf16_t*)(p->ws + WS_D_PRW); bf16_t* L = (bf16_t*)(p->ws + WS_D_L);
    const int gtid = blockIdx.x * 512 + launder_tid(wvs), gsz = gridDim.x * 512;
    for (int item = gtid; item < MTOK * 32; item += gsz) {
        const int row = item >> 5, c8 = (item & 31) * 8;
        const u32x4 cur = *(const u32x4*)(prw + (size_t)row * 1792 + 1536 + c8);
        u32x4 prv = {0u, 0u, 0u, 0u};
        if ((row & (SEQ - 1)) != 0) prv = *(const u32x4*)(prw + (size_t)(row - 1) * 1792 + 1536 + c8);
        const f32x4 m0 = *(const f32x4*)(p->rwkv_mu + 1536 + c8), m1 = *(const f32x4*)(p->rwkv_mu + 1536 + c8 + 4);
        float v[8];
#pragma unroll
        for (int i = 0; i < 4; ++i) {
            const float c0 = bflo(cur[i]), c1 = bfhi(cur[i]), p0 = bflo(prv[i]), p1 = bfhi(prv[i]);
            const float mu0 = (i < 2) ? m0[2 * i] : m1[2 * i - 4], mu1 = (i < 2) ? m0[2 * i + 1] : m1[2 * i - 3];
            v[2 * i] = c0 + (p0 - c0) * mu0; v[2 * i + 1] = c1 + (p1 - c1) * mu1;
        }
        if (c8 < 64) {
#pragma unroll
            for (int i = 0; i < 8; ++i) { const float e = __expf(2.f * v[i]); v[i] = 1.f - 2.f * __builtin_amdgcn_rcpf(e + 1.f); }
        } else if (c8 >= 128) {
#pragma unroll
            for (int i = 0; i < 8; ++i) v[i] = __builtin_amdgcn_rcpf(1.f + __expf(-v[i]));
        }
        u32x4 o; o.x = pk2(v[0], v[1]); o.y = pk2(v[2], v[3]); o.z = pk2(v[4], v[5]); o.w = pk2(v[6], v[7]);
        *(u32x4*)(L + (size_t)row * 256 + c8) = o;
    }
}

__device__ __forceinline__ void lds_barrier() { asm volatile("s_waitcnt lgkmcnt(0)" ::: "memory"); __builtin_amdgcn_s_barrier(); asm volatile("" ::: "memory"); }
typedef float f32x2 __attribute__((ext_vector_type(2)));
__device__ __forceinline__ void rwkv_scan_unit(KP p, const int unit, const int wvs) {
    const int b = unit >> 3, h = unit & 7;
    const int tid = launder_tid(wvs), wid = tid >> 6, lane = tid & 63;
    constexpr int TC = 16, NC = SEQ / TC;
    float* bufs = (float*)smem;
    float* yl = bufs + 2 * TC * 384;
    if (__builtin_amdgcn_readfirstlane(wid) < 4) {
        const int il = lane >> 3, jg = lane & 7, i0 = wid * 16 + il, i1 = i0 + 8;
        f32x2 A0 = {0.f, 0.f}, A1 = A0, A2 = A0, A3 = A0, B0 = A0, B1 = A0, B2 = A0, B3 = A0;
#define SC_LOAD(S, t_) do { const float* sn_ = sp + (t_) * 384; \
        a0##S = *(const f32x4*)(sn_); a1##S = *(const f32x4*)(sn_ + 4); w0##S = *(const f32x4*)(sn_ + 64); w1##S = *(const f32x4*)(sn_ + 68); \
        b0##S = *(const f32x4*)(sn_ + 128); b1##S = *(const f32x4*)(sn_ + 132); k0##S = *(const f32x4*)(sn_ + 192); k1##S = *(const f32x4*)(sn_ + 196); \
        r0##S = *(const f32x4*)(sn_ + 256); r1##S = *(const f32x4*)(sn_ + 260); v0##S = buf[(t_) * 384 + 320 + i0]; v1##S = buf[(t_) * 384 + 320 + i1]; } while (0)
#define SC_STEP(S, t_) do { \
        f32x2 ta = A0 * a0##S.xy; ta = A1 * a0##S.zw + ta; ta = A2 * a1##S.xy + ta; ta = A3 * a1##S.zw + ta; \
        f32x2 tb = B0 * a0##S.xy; tb = B1 * a0##S.zw + tb; tb = B2 * a1##S.xy + tb; tb = B3 * a1##S.zw + tb; \
        float sa = ta.x + ta.y, sb = tb.x + tb.y; sa = red8(sa); sb = red8(sb); \
        const f32x2 sa2 = {sa, sa}, sb2 = {sb, sb}, va2 = {v0##S, v0##S}, vb2 = {v1##S, v1##S}; \
        A0 = A0 * w0##S.xy + (sa2 * b0##S.xy + va2 * k0##S.xy); A1 = A1 * w0##S.zw + (sa2 * b0##S.zw + va2 * k0##S.zw); \
        A2 = A2 * w1##S.xy + (sa2 * b1##S.xy + va2 * k1##S.xy); A3 = A3 * w1##S.zw + (sa2 * b1##S.zw + va2 * k1##S.zw); \
        B0 = B0 * w0##S.xy + (sb2 * b0##S.xy + vb2 * k0##S.xy); B1 = B1 * w0##S.zw + (sb2 * b0##S.zw + vb2 * k0##S.zw); \
        B2 = B2 * w1##S.xy + (sb2 * b1##S.xy + vb2 * k1##S.xy); B3 = B3 * w1##S.zw + (sb2 * b1##S.zw + vb2 * k1##S.zw); \
        f32x2 ua = A0 * r0##S.xy; ua = A1 * r0##S.zw + ua; ua = A2 * r1##S.xy + ua; ua = A3 * r1##S.zw + ua; \
        f32x2 ub = B0 * r0##S.xy; ub = B1 * r0##S.zw + ub; ub = B2 * r1##S.xy + ub; ub = B3 * r1##S.zw + ub; \
        yb[(t_) * 512 + i0 * 8 + jg] = ua.x + ua.y; yb[(t_) * 512 + i1 * 8 + jg] = ub.x + ub.y; } while (0)
        lds_barrier();
        for (int c = 0; c < NC; ++c) {
            const float* buf = bufs + (c & 1) * (TC * 384);
            float* yb = yl + (c & 1) * (TC * 512);
            const float* sp = buf + jg * 8;
            f32x4 a0X, a1X, w0X, w1X, b0X, b1X, k0X, k1X, r0X, r1X, a0Y, a1Y, w0Y, w1Y, b0Y, b1Y, k0Y, k1Y, r0Y, r1Y; float v0X, v1X, v0Y, v1Y;
            SC_LOAD(X, 0);
#pragma unroll
            for (int t = 0; t < TC; t += 2) {
                SC_LOAD(Y, t + 1);
                SC_STEP(X, t);
                if (t + 2 < TC) SC_LOAD(X, t + 2);
                SC_STEP(Y, t + 1);
            }
            lds_barrier();
        }
        lds_barrier();
#undef SC_LOAD
#undef SC_STEP
    } else {
        const bf16_t* prw = (const bf16_t*)(p->ws + WS_D_PRW);
        const bf16_t* Wb = (const bf16_t*)(p->ws + WS_D_W);
        const bf16_t* AGb = (const bf16_t*)(p->ws + WS_D_AG);
        const bf16_t* Gb = (const bf16_t*)(p->ws + WS_D_G);
        bf16_t* YC = (bf16_t*)(p->ws + WS_H);
        const int ptid = tid - 256, st = ptid >> 4, sc = (ptid & 15) * 4, ch = h * 64 + sc;
        const f32x4 mu_r = *(const f32x4*)(p->rwkv_mu + ch), mu_k = *(const f32x4*)(p->rwkv_mu + 512 + ch), mu_v = *(const f32x4*)(p->rwkv_mu + 1024 + ch);
        const f32x4 kkc = *(const f32x4*)(p->rwkv_k_k + ch), kac = *(const f32x4*)(p->rwkv_k_a + ch), rkc = *(const f32x4*)(p->rwkv_r_k + ch);
        const f32x4 lnw = *(const f32x4*)(p->rwkv_ln_w + ch), lnb = *(const f32x4*)(p->rwkv_ln_b + ch);
        const f32x4 w0c = *(const f32x4*)(p->rwkv_w0 + ch), a0c = *(const f32x4*)(p->rwkv_a0 + ch);
        u32x2 r_c, r_p, k_c, k_p, v_c, v_p, w_r, ag_r, g_r;
#define RW_LOAD(c) do { const int t_ = (c) * TC + st; const size_t row_ = (size_t)b * SEQ + t_; const bf16_t* pr_ = prw + row_ * 1792 + ch; \
        r_c = *(const u32x2*)(pr_); k_c = *(const u32x2*)(pr_ + 512); v_c = *(const u32x2*)(pr_ + 1024); \
        if (t_ > 0) { r_p = *(const u32x2*)(pr_ - 1792); k_p = *(const u32x2*)(pr_ - 1792 + 512); v_p = *(const u32x2*)(pr_ - 1792 + 1024); } \
        else { r_p = (u32x2){0u, 0u}; k_p = r_p; v_p = r_p; } \
        w_r = *(const u32x2*)(Wb + row_ * 512 + ch); ag_r = *(const u32x2*)(AGb + row_ * 512 + ch); } while (0)
#define RW_WRITE(buf) do { float* d_ = (buf) + st * 384 + sc; \
        f32x4 rr_, kk_, vv_, ag_, ew_; \
        for (int e = 0; e < 2; ++e) { \
            { const float c0 = bflo(r_c[e]), c1 = bfhi(r_c[e]), p0 = bflo(r_p[e]), p1 = bfhi(r_p[e]); rr_[2 * e] = c0 + (p0 - c0) * mu_r[2 * e]; rr_[2 * e + 1] = c1 + (p1 - c1) * mu_r[2 * e + 1]; } \
            { const float c0 = bflo(k_c[e]), c1 = bfhi(k_c[e]), p0 = bflo(k_p[e]), p1 = bfhi(k_p[e]); kk_[2 * e] = c0 + (p0 - c0) * mu_k[2 * e]; kk_[2 * e + 1] = c1 + (p1 - c1) * mu_k[2 * e + 1]; } \
            { const float c0 = bflo(v_c[e]), c1 = bfhi(v_c[e]), p0 = bflo(v_p[e]), p1 = bfhi(v_p[e]); vv_[2 * e] = c0 + (p0 - c0) * mu_v[2 * e]; vv_[2 * e + 1] = c1 + (p1 - c1) * mu_v[2 * e + 1]; } \
            ag_[2 * e] = sigmoid_fast(bflo(ag_r[e]) + a0c[2 * e]); ag_[2 * e + 1] = sigmoid_fast(bfhi(ag_r[e]) + a0c[2 * e + 1]); \
            ew_[2 * e] = 0.60653066f * sigmoid_fast(bflo(w_r[e]) + w0c[2 * e]); ew_[2 * e + 1] = 0.60653066f * sigmoid_fast(bfhi(w_r[e]) + w0c[2 * e + 1]); } \
        const f32x4 kn_ = kk_ * kkc; float ss_ = (kn_[0] * kn_[0] + kn_[1] * kn_[1]) + (kn_[2] * kn_[2] + kn_[3] * kn_[3]); ss_ = red16(ss_); \
        const float rn_ = rsqrtf(fmaxf(ss_, 1e-24f)); const f32x4 kkn_ = kn_ * rn_; \
        f32x4 dec_; for (int e = 0; e < 4; ++e) dec_[e] = __expf(-ew_[e]); \
        *(f32x4*)(d_) = -kkn_; *(f32x4*)(d_ + 64) = dec_; *(f32x4*)(d_ + 128) = kkn_ * ag_; \
        *(f32x4*)(d_ + 192) = kk_ * (1.0f + (ag_ - 1.0f) * kac); *(f32x4*)(d_ + 256) = rr_; *(f32x4*)(d_ + 320) = vv_; } while (0)
#define RW_POST(c) do { const float* buf_ = bufs + ((c) & 1) * (TC * 384); const float* yp_ = yl + ((c) & 1) * (TC * 512) + st * 512 + sc * 8; \
            f32x4 y4; \
            for (int e = 0; e < 4; ++e) { const f32x4 q0 = *(const f32x4*)(yp_ + e * 8), q1 = *(const f32x4*)(yp_ + e * 8 + 4); y4[e] = ((q0[0] + q0[1]) + (q0[2] + q0[3])) + ((q1[0] + q1[1]) + (q1[2] + q1[3])); } \
            float s = (y4[0] + y4[1]) + (y4[2] + y4[3]); s = red16(s); \
            const float mean = s * (1.0f / 64.0f); const f32x4 d = y4 - mean; \
            float q = (d[0] * d[0] + d[1] * d[1]) + (d[2] * d[2] + d[3] * d[3]); q = red16(q); \
            const float rstd = rsqrtf(q * (1.0f / 64.0f) + 64e-5f); \
            const f32x4 rr = *(const f32x4*)(buf_ + st * 384 + 256 + sc), km = *(const f32x4*)(buf_ + st * 384 + 192 + sc), vv = *(const f32x4*)(buf_ + st * 384 + 320 + sc); \
            const f32x4 bt = rr * km * rkc; float bonus = (bt[0] + bt[1]) + (bt[2] + bt[3]); bonus = red16(bonus); \
            f32x4 gg; gg[0] = bflo(g_r[0]); gg[1] = bfhi(g_r[0]); gg[2] = bflo(g_r[1]); gg[3] = bfhi(g_r[1]); \
            const f32x4 o = ((d * rstd) * lnw + lnb + bonus * vv) * gg; \
            u32x2 w; w.x = pk2(o[0], o[1]); w.y = pk2(o[2], o[3]); \
            const size_t row_ = (size_t)b * SEQ + (c) * TC + st; \
            *(u32x2*)(YC + row_ * 1024 + ch) = w; } while (0)
#define RW_GLOAD(c) do { const size_t row_ = (size_t)b * SEQ + (c) * TC + st; g_r = *(const u32x2*)(Gb + row_ * 512 + ch); } while (0)
        RW_LOAD(0);
        RW_WRITE(bufs);
        RW_LOAD(1);
        lds_barrier();
        for (int c = 0; c < NC; ++c) {
            if (c >= 1) { RW_POST(c - 1); }
            RW_GLOAD(c);
            if (c + 1 < NC) RW_WRITE(bufs + ((c + 1) & 1) * (TC * 384));
            if (c + 2 < NC) RW_LOAD(c + 2);
            lds_barrier();
        }
        RW_POST(NC - 1);
        lds_barrier();
#undef RW_LOAD
#undef RW_WRITE
#undef RW_POST
#undef RW_GLOAD
    }
}

__device__ __forceinline__ int tsw(int row, int col) { return row * 72 + (col ^ (((row >> 3) & 7) << 3)); }
__device__ __forceinline__ bf16x8 pack_acc2(const f32x4 a, const f32x4 b) {
    const unsigned x0 = pk2(a[0], a[1]), x1 = pk2(a[2], a[3]), x2 = pk2(b[0], b[1]), x3 = pk2(b[2], b[3]);
    const u32x4 u = {x0, x1, x2, x3}; return __builtin_bit_cast(bf16x8, u);
}
__device__ __forceinline__ bf16x8 ld_2x4(const bf16_t* p0, const bf16_t* p1) {
    const u32x2 lo = *(const u32x2*)p0, hi = *(const u32x2*)p1; const u32x4 u = {lo[0], lo[1], hi[0], hi[1]}; return __builtin_bit_cast(bf16x8, u);
}

__device__ __forceinline__ void retention_unit(KP p, const int unit, const int wvs) {
    const int b = unit >> 2, h = unit & 3;
    const int tid = launder_tid(wvs), wid = tid >> 6, lane = tid & 63, fr = lane & 15, fq = lane >> 4, tb = wid & 3, eh = wid >> 2;
    bf16_t* Qs = (bf16_t*)smem;
    bf16_t* Ks = Qs + 64 * 136;
    bf16_t* Vt = Ks + 64 * 136;
    bf16_t* Kt = Vt + 128 * 72;
    bf16_t* STs = Kt + 128 * 72;
    float* red = (float*)(STs + 128 * 136);
    const bf16_t* pret = (const bf16_t*)(p->ws + WS_C);
    const float* cosT = (const float*)(p->ws + WS_COS); const float* sinT = (const float*)(p->ws + WS_SIN);
    bf16_t* YC = (bf16_t*)(p->ws + WS_H);
    const float lg2 = log2f(1.0f - exp2f(-5.0f - (float)h));
    const float cd = exp2f(lg2 * 64.0f);
    for (int i = tid; i < 128 * 136 / 2; i += 512) ((unsigned*)STs)[i] = 0u;
    f32x4 accST[8];
#pragma unroll
    for (int i = 0; i < 8; ++i) accST[i] = (f32x4){0.f, 0.f, 0.f, 0.f};
    u32x2 q1[2], q2[2], k1[2], k2[2]; f32x4 cs[2], sn[2]; u32x4 vr[2];
#define RT_LOAD(c) do { for (int pp = 0; pp < 2; ++pp) { const int item = tid + pp * 512, t_ = item >> 4, i4 = (item & 15) * 4, pos = (c) * 64 + t_; \
            const bf16_t* pr_ = pret + ((size_t)b * SEQ + pos) * 2048 + h * 128 + i4; \
            q1[pp] = *(const u32x2*)(pr_); q2[pp] = *(const u32x2*)(pr_ + 64); k1[pp] = *(const u32x2*)(pr_ + 512); k2[pp] = *(const u32x2*)(pr_ + 512 + 64); \
            cs[pp] = *(const f32x4*)(cosT + pos * 64 + i4); sn[pp] = *(const f32x4*)(sinT + pos * 64 + i4); \
            const int e8 = (item & 15) * 8; vr[pp] = *(const u32x4*)(pret + ((size_t)b * SEQ + pos) * 2048 + 1024 + h * 128 + e8); } } while (0)
#define RT_WRITE() do { for (int pp = 0; pp < 2; ++pp) { const int item = tid + pp * 512, t_ = item >> 4, i4 = (item & 15) * 4; \
            f32x4 a1_, a2_; a1_[0] = bflo(q1[pp][0]); a1_[1] = bfhi(q1[pp][0]); a1_[2] = bflo(q1[pp][1]); a1_[3] = bfhi(q1[pp][1]); \
            a2_[0] = bflo(q2[pp][0]); a2_[1] = bfhi(q2[pp][0]); a2_[2] = bflo(q2[pp][1]); a2_[3] = bfhi(q2[pp][1]); \
            f32x4 o1_ = a1_ * cs[pp] - a2_ * sn[pp], o2_ = a1_ * sn[pp] + a2_ * cs[pp]; \
            u32x2 w_; w_.x = pk2(o1_[0], o1_[1]); w_.y = pk2(o1_[2], o1_[3]); *(u32x2*)(Qs + t_ * 136 + i4) = w_; \
            w_.x = pk2(o2_[0], o2_[1]); w_.y = pk2(o2_[2], o2_[3]); *(u32x2*)(Qs + t_ * 136 + 64 + i4) = w_; \
            a1_[0] = bflo(k1[pp][0]); a1_[1] = bfhi(k1[pp][0]); a1_[2] = bflo(k1[pp][1]); a1_[3] = bfhi(k1[pp][1]); \
            a2_[0] = bflo(k2[pp][0]); a2_[1] = bfhi(k2[pp][0]); a2_[2] = bflo(k2[pp][1]); a2_[3] = bfhi(k2[pp][1]); \
            o1_ = (a1_ * cs[pp] - a2_ * sn[pp]) * 0.08838834764831845f; o2_ = (a1_ * sn[pp] + a2_ * cs[pp]) * 0.08838834764831845f; \
            w_.x = pk2(o1_[0], o1_[1]); w_.y = pk2(o1_[2], o1_[3]); *(u32x2*)(Ks + t_ * 136 + i4) = w_; \
            w_.x = pk2(o2_[0], o2_[1]); w_.y = pk2(o2_[2], o2_[3]); *(u32x2*)(Ks + t_ * 136 + 64 + i4) = w_; \
            const float kd_ = exp2f(lg2 * (float)(63 - t_)); \
            for (int e = 0; e < 4; ++e) { Kt[tsw(i4 + e, t_)] = f2bf(o1_[e] * kd_); Kt[tsw(64 + i4 + e, t_)] = f2bf(o2_[e] * kd_); } \
            const int e8 = (item & 15) * 8; \
            for (int e = 0; e < 4; ++e) { Vt[tsw(e8 + 2 * e, t_)] = (bf16_t)(vr[pp][e] & 0xffffu); Vt[tsw(e8 + 2 * e + 1, t_)] = (bf16_t)(vr[pp][e] >> 16); } } } while (0)
    RT_LOAD(0);
    RT_WRITE();
    lds_barrier();
    for (int c = 0; c < SEQ / 64; ++c) {
        if (c + 1 < SEQ / 64) RT_LOAD(c + 1);
        bf16x8 qf[4];
#pragma unroll
        for (int ks = 0; ks < 4; ++ks) qf[ks] = *(const bf16x8*)(Qs + (tb * 16 + fr) * 136 + ks * 32 + fq * 8);
        f32x4 sT[4];
#pragma unroll
        for (int s_ = 0; s_ < 4; ++s_) { sT[s_] = (f32x4){0.f, 0.f, 0.f, 0.f};
#pragma unroll
            for (int ks = 0; ks < 4; ++ks) { const bf16x8 kf = *(const bf16x8*)(Ks + (s_ * 16 + fr) * 136 + ks * 32 + fq * 8);
                sT[s_] = __builtin_amdgcn_mfma_f32_16x16x32_bf16(kf, qf[ks], sT[s_], 0, 0, 0); } }
        const int tl = tb * 16 + fr;
#pragma unroll
        for (int s_ = 0; s_ < 4; ++s_)
#pragma unroll
            for (int r = 0; r < 4; ++r) { const int sl = s_ * 16 + fq * 4 + r; sT[s_][r] = (sl <= tl) ? sT[s_][r] * exp2f(lg2 * (float)(tl - sl)) : 0.f; }
        f32x4 acc[4];
#pragma unroll
        for (int et = 0; et < 4; ++et) { acc[et] = (f32x4){0.f, 0.f, 0.f, 0.f};
#pragma unroll
            for (int ks = 0; ks < 4; ++ks) { const bf16x8 sf = *(const bf16x8*)(STs + ((eh * 4 + et) * 16 + fr) * 136 + ks * 32 + fq * 8);
                acc[et] = __builtin_amdgcn_mfma_f32_16x16x32_bf16(sf, qf[ks], acc[et], 0, 0, 0); } }
        const float qd = exp2f(lg2 * (float)(tl + 1));
#pragma unroll
        for (int et = 0; et < 4; ++et) acc[et] = acc[et] * qd;
#pragma unroll
        for (int k2_ = 0; k2_ < 2; ++k2_) { const bf16x8 bfr = pack_acc2(sT[2 * k2_], sT[2 * k2_ + 1]);
#pragma unroll
            for (int et = 0; et < 4; ++et) { const int vr_ = (eh * 4 + et) * 16 + fr;
                const bf16x8 af = ld_2x4(Vt + tsw(vr_, (2 * k2_) * 16 + fq * 4), Vt + tsw(vr_, (2 * k2_ + 1) * 16 + fq * 4));
                acc[et] = __builtin_amdgcn_mfma_f32_16x16x32_bf16(af, bfr, acc[et], 0, 0, 0); } }
        float ss = 0.f;
#pragma unroll
        for (int et = 0; et < 4; ++et) ss += (acc[et][0] * acc[et][0] + acc[et][1] * acc[et][1]) + (acc[et][2] * acc[et][2] + acc[et][3] * acc[et][3]);
        ss += __shfl_xor(ss, 16); ss += __shfl_xor(ss, 32);
        if (fq == 0) red[eh * 64 + tl] = ss;
#pragma unroll
        for (int dt = 0; dt < 8; ++dt) accST[dt] = accST[dt] * cd;
#pragma unroll
        for (int ks = 0; ks < 2; ++ks) { const bf16x8 af = *(const bf16x8*)(Vt + tsw(wid * 16 + fr, ks * 32 + fq * 8));
#pragma unroll
            for (int dt = 0; dt < 8; ++dt) { const bf16x8 bfr = *(const bf16x8*)(Kt + tsw(dt * 16 + fr, ks * 32 + fq * 8));
                accST[dt] = __builtin_amdgcn_mfma_f32_16x16x32_bf16(af, bfr, accST[dt], 0, 0, 0); } }
        lds_barrier();
        {
            const float tot = red[tl] + red[64 + tl];
            const float rn = rsqrtf(tot * (1.0f / 128.0f) + 1e-6f);
            const size_t row_ = (size_t)b * SEQ + c * 64 + tl;
#pragma unroll
            for (int et = 0; et < 4; ++et) { const int e0 = (eh * 4 + et) * 16 + fq * 4;
                const u32x2 gr = *(const u32x2*)(pret + row_ * 2048 + 1536 + h * 128 + e0);
                f32x4 g; g[0] = bflo(gr[0]); g[1] = bfhi(gr[0]); g[2] = bflo(gr[1]); g[3] = bfhi(gr[1]);
                f32x4 o; for (int r = 0; r < 4; ++r) o[r] = acc[et][r] * rn * (g[r] * sigmoidf_(g[r]));
                u32x2 w; w.x = pk2(o[0], o[1]); w.y = pk2(o[2], o[3]);
                *(u32x2*)(YC + row_ * 1024 + 512 + h * 128 + e0) = w; }
        }
#pragma unroll
        for (int dt = 0; dt < 8; ++dt)
#pragma unroll
            for (int r = 0; r < 4; ++r) STs[(wid * 16 + fq * 4 + r) * 136 + dt * 16 + fr] = f2bf(accST[dt][r]);
        if (c + 1 < SEQ / 64) RT_WRITE();
        lds_barrier();
    }
#undef RT_LOAD
#undef RT_WRITE
}

__device__ __forceinline__ float softcapf(float x) { const float e = __expf(2.f * x * (1.0f / 15.0f)); return 15.0f * (1.f - 2.f / (e + 1.f)); }

__device__ __forceinline__ void mlstm_unit(KP p, const int unit, const int wvs) {
    const int par = unit & 1, bh = unit >> 1, b = bh >> 3, h = bh & 7;
    const int tid = launder_tid(wvs), wid = tid >> 6, lane = tid & 63, fr = lane & 15, fq = lane >> 4, tb = wid & 3, eh = wid >> 2;
    bf16_t* Qs = (bf16_t*)smem;
    bf16_t* Ks = Qs + 64 * 72;
    bf16_t* Vt = Ks + 64 * 72;
    bf16_t* Kt = Vt + 144 * 72;
    bf16_t* CTs = Kt + 64 * 72;
    float* red = (float*)(CTs + 144 * 72);
    float* cwl = red + 128;
    float* nwl = cwl + 640;
    float* Gs = nwl + 128;
    float* Mx = Gs + 64 * 68;
    float* Ee = Mx + 64 * 68;
    const bf16_t* pc = (const bf16_t*)(p->ws + WS_D);
    const float* gates = (const float*)(p->ws + WS_GATES);
    bf16_t* YC = (bf16_t*)(p->ws + WS_H);
    for (int i = tid; i < 144 * 72 / 2; i += 512) ((unsigned*)CTs)[i] = 0u;
    for (int i = tid; i < 16 * 72 / 2; i += 512) ((unsigned*)(Vt + 128 * 72))[i] = (i < 36) ? 0x3F803F80u : 0u;
    for (int i = tid; i < 640; i += 512) { const int j = i >> 7, cc = i & 127; const int col = (cc >> 6) * 512 + h * 64 + (cc & 63);
        cwl[i] = (j < 4) ? p->c_conv_w[j * 1024 + col] : p->c_conv_b[col]; }
    if (tid < 128) nwl[tid] = p->c_norm_w[h * 128 + tid];
    if (wid == 0) {
        const float ibias = p->c_i_bias[h], fbias = p->c_f_bias[h];
        const float* gr = gates + ((size_t)b * SEQ + lane * 64) * 16 + h;
        float bsum = 0.f;
        for (int i = 0; i < 64; ++i) { const float li = softcapf(gr[i * 16] + ibias), lf = -log1pf(__expf(-softcapf(gr[i * 16 + 8] + fbias)));
            bsum += lf; Gs[lane * 68 + i] = li; Ee[lane * 68 + i] = lf; }
        float inc = bsum;
        for (int o = 1; o < 64; o <<= 1) { const float n_ = __shfl_up(inc, o); if (lane >= o) inc += n_; }
        float Bc = inc - bsum, lmax = -3.0e38f;
        for (int i = 0; i < 64; ++i) { Bc += Ee[lane * 68 + i]; const float g = Gs[lane * 68 + i] - Bc; Gs[lane * 68 + i] = g; Ee[lane * 68 + i] = Bc; lmax = fmaxf(lmax, g); }
        float pm = lmax;
        for (int o = 1; o < 64; o <<= 1) { const float n_ = __shfl_up(pm, o); if (lane >= o) pm = fmaxf(pm, n_); }
        float run = __shfl_up(pm, 1); if (lane == 0) run = 0.f; run = fmaxf(run, 0.f);
        for (int i = 0; i < 64; ++i) { run = fmaxf(run, Gs[lane * 68 + i]); Mx[lane * 68 + i] = run; Ee[lane * 68 + i] += run; }
    }
    f32x4 accC[4], accCa;
#pragma unroll
    for (int i = 0; i < 4; ++i) accC[i] = (f32x4){0.f, 0.f, 0.f, 0.f};
    accCa = (f32x4){0.f, 0.f, 0.f, 0.f};
    const int gidx = tid & 15, isK = gidx >> 3, c8 = (gidx & 7) * 8, ccol = isK * 512 + h * 64 + c8, lcol = isK * 64 + c8;
    const int tK = tid >> 3, c8K = (tid & 7) * 8, ccolK = 512 + h * 64 + c8K, lcolK = 64 + c8K;
    u32x4 xr[2][4]; u32x4 vr[2]; u32x2 og[4];
#define ML_LDX(dst, t_, pos_, col_) do { const bf16_t* pr_ = pc + ((size_t)b * SEQ + (pos_)) * 3072; \
        for (int j = 0; j < 4; ++j) { if ((pos_) - 3 + j >= 0) dst[j] = *(const u32x4*)(pr_ + (long)(j - 3) * 3072 + (col_)); else dst[j] = (u32x4){0u, 0u, 0u, 0u}; } } while (0)
#define ML_LOAD(c) do { if ((((c) & 1) == par)) { for (int pp = 0; pp < 2; ++pp) { const int t_ = (tid + pp * 512) >> 4; ML_LDX(xr[pp], t_, (c) * 64 + t_, ccol); } } \
        else { ML_LDX(xr[0], tK, (c) * 64 + tK, ccolK); } \
        for (int pp = 0; pp < 2; ++pp) { const int item = tid + pp * 512, t_ = item >> 4, e8 = (item & 15) * 8; \
            vr[pp] = *(const u32x4*)(pc + ((size_t)b * SEQ + (c) * 64 + t_) * 3072 + 1024 + h * 128 + e8); } } while (0)
#define ML_CONV(src, lcol_, y_) do { \
            { const f32x4 b0_ = *(const f32x4*)(cwl + 512 + (lcol_)), b1_ = *(const f32x4*)(cwl + 512 + (lcol_) + 4); \
              y_[0] = b0_[0]; y_[1] = b0_[1]; y_[2] = b0_[2]; y_[3] = b0_[3]; y_[4] = b1_[0]; y_[5] = b1_[1]; y_[6] = b1_[2]; y_[7] = b1_[3]; } \
            for (int j = 0; j < 4; ++j) { const f32x4 w0_ = *(const f32x4*)(cwl + j * 128 + (lcol_)), w1_ = *(const f32x4*)(cwl + j * 128 + (lcol_) + 4); \
                y_[0] += w0_[0] * bflo(src[j][0]); y_[1] += w0_[1] * bfhi(src[j][0]); y_[2] += w0_[2] * bflo(src[j][1]); y_[3] += w0_[3] * bfhi(src[j][1]); \
                y_[4] += w1_[0] * bflo(src[j][2]); y_[5] += w1_[1] * bfhi(src[j][2]); y_[6] += w1_[2] * bflo(src[j][3]); y_[7] += w1_[3] * bfhi(src[j][3]); } \
            for (int e = 0; e < 8; ++e) y_[e] = y_[e] * sigmoid_fast(y_[e]); } while (0)
#define ML_KOUT(y_, t_, c8_) do { for (int e = 0; e < 8; ++e) y_[e] *= 0.125f; \
                u32x4 o_; o_.x = pk2(y_[0], y_[1]); o_.y = pk2(y_[2], y_[3]); o_.z = pk2(y_[4], y_[5]); o_.w = pk2(y_[6], y_[7]); *(u32x4*)(Ks + (t_) * 72 + (c8_)) = o_; \
                const float kw_ = __expf(ga_[(t_)] - M63_); for (int e = 0; e < 8; ++e) Kt[tsw((c8_) + e, (t_))] = f2bf(y_[e] * kw_); } while (0)
#define ML_WRITE(c) do { const float* ga_ = Gs + (c) * 68; const float M63_ = Mx[(c) * 68 + 63]; \
        if ((((c) & 1) == par)) { for (int pp = 0; pp < 2; ++pp) { const int t_ = (tid + pp * 512) >> 4; float y_[8]; ML_CONV(xr[pp], lcol, y_); \
                if (isK == 0) { u32x4 o_; o_.x = pk2(y_[0], y_[1]); o_.y = pk2(y_[2], y_[3]); o_.z = pk2(y_[4], y_[5]); o_.w = pk2(y_[6], y_[7]); *(u32x4*)(Qs + t_ * 72 + c8) = o_; } \
                else ML_KOUT(y_, t_, c8); } } \
        else { float y_[8]; ML_CONV(xr[0], lcolK, y_); ML_KOUT(y_, tK, c8K); } \
        for (int pp = 0; pp < 2; ++pp) { const int item = tid + pp * 512, t_ = item >> 4, e8 = (item & 15) * 8; \
            for (int e = 0; e < 4; ++e) { Vt[tsw(e8 + 2 * e, t_)] = (bf16_t)(vr[pp][e] & 0xffffu); Vt[tsw(e8 + 2 * e + 1, t_)] = (bf16_t)(vr[pp][e] >> 16); } } } while (0)
    ML_LOAD(0);
    lds_barrier();
    ML_WRITE(0);
    lds_barrier();
    for (int c = 0; c < SEQ / 64; ++c) {
        const float* ga = Gs + c * 68;
        const bool own = ((c & 1) == par);
        if (c + 1 < SEQ / 64) ML_LOAD(c + 1);
        const int tl = tb * 16 + fr;
        const float M63 = Mx[c * 68 + 63];
        const float Mprev = (c == 0) ? 0.f : Mx[(c - 1) * 68 + 63];
        f32x4 acc[5];
        if (own) {
            {
                const size_t row_ = (size_t)b * SEQ + c * 64 + tl;
#pragma unroll
                for (int et = 0; et < 4; ++et) og[et] = *(const u32x2*)(pc + row_ * 3072 + 2048 + h * 128 + (eh * 4 + et) * 16 + fq * 4);
            }
            bf16x8 qf[2];
#pragma unroll
            for (int ks = 0; ks < 2; ++ks) qf[ks] = *(const bf16x8*)(Qs + tl * 72 + ks * 32 + fq * 8);
            f32x4 sT[4];
#pragma unroll
            for (int s_ = 0; s_ < 4; ++s_) { sT[s_] = (f32x4){0.f, 0.f, 0.f, 0.f};
#pragma unroll
                for (int ks = 0; ks < 2; ++ks) { const bf16x8 kf = *(const bf16x8*)(Ks + (s_ * 16 + fr) * 72 + ks * 32 + fq * 8);
                    sT[s_] = __builtin_amdgcn_mfma_f32_16x16x32_bf16(kf, qf[ks], sT[s_], 0, 0, 0); } }
            const float Mt = Mx[c * 68 + tl], Et = Ee[c * 68 + tl];
#pragma unroll
            for (int s_ = 0; s_ < 4; ++s_) { const f32x4 g4 = *(const f32x4*)(ga + s_ * 16 + fq * 4);
#pragma unroll
                for (int r = 0; r < 4; ++r) { const int sl = s_ * 16 + fq * 4 + r; sT[s_][r] = (sl <= tl) ? sT[s_][r] * __expf(g4[r] - Mt) : 0.f; } }
#pragma unroll
            for (int et = 0; et < 5; ++et) { acc[et] = (f32x4){0.f, 0.f, 0.f, 0.f}; const int etile = (et < 4) ? (eh * 4 + et) : 8;
#pragma unroll
                for (int ks = 0; ks < 2; ++ks) { const bf16x8 cf = *(const bf16x8*)(CTs + (etile * 16 + fr) * 72 + ks * 32 + fq * 8);
                    acc[et] = __builtin_amdgcn_mfma_f32_16x16x32_bf16(cf, qf[ks], acc[et], 0, 0, 0); } }
            const float inter = __expf(Mprev - Mt);
#pragma unroll
            for (int et = 0; et < 5; ++et) acc[et] = acc[et] * inter;
#pragma unroll
            for (int k2_ = 0; k2_ < 2; ++k2_) { const bf16x8 bfr = pack_acc2(sT[2 * k2_], sT[2 * k2_ + 1]);
#pragma unroll
                for (int et = 0; et < 5; ++et) { const int etile = (et < 4) ? (eh * 4 + et) : 8; const int vr_ = etile * 16 + fr;
                    const bf16x8 af = ld_2x4(Vt + tsw(vr_, (2 * k2_) * 16 + fq * 4), Vt + tsw(vr_, (2 * k2_ + 1) * 16 + fq * 4));
                    acc[et] = __builtin_amdgcn_mfma_f32_16x16x32_bf16(af, bfr, acc[et], 0, 0, 0); } }
            const float den = __shfl(acc[4][0], fr);
            const float dn = 1.0f / fmaxf(fabsf(den), __expf(-Et));
            float ss = 0.f;
#pragma unroll
            for (int et = 0; et < 4; ++et) { acc[et] = acc[et] * dn; ss += (acc[et][0] * acc[et][0] + acc[et][1] * acc[et][1]) + (acc[et][2] * acc[et][2] + acc[et][3] * acc[et][3]); }
            ss += __shfl_xor(ss, 16); ss += __shfl_xor(ss, 32);
            if (fq == 0) red[eh * 64 + tl] = ss;
        }
        const float csc = __expf(Mprev - M63);
#pragma unroll
        for (int dt = 0; dt < 4; ++dt) accC[dt] = accC[dt] * csc;
        accCa = accCa * csc;
#pragma unroll
        for (int ks = 0; ks < 2; ++ks) { const bf16x8 af = *(const bf16x8*)(Vt + tsw(wid * 16 + fr, ks * 32 + fq * 8));
#pragma unroll
            for (int dt = 0; dt < 4; ++dt) { const bf16x8 bfr = *(const bf16x8*)(Kt + tsw(dt * 16 + fr, ks * 32 + fq * 8));
                accC[dt] = __builtin_amdgcn_mfma_f32_16x16x32_bf16(af, bfr, accC[dt], 0, 0, 0); }
            if (wid < 4) { const bf16x8 aa = *(const bf16x8*)(Vt + tsw(128 + fr, ks * 32 + fq * 8)), bb = *(const bf16x8*)(Kt + tsw(wid * 16 + fr, ks * 32 + fq * 8));
                accCa = __builtin_amdgcn_mfma_f32_16x16x32_bf16(aa, bb, accCa, 0, 0, 0); } }
        lds_barrier();
        if (own) {
            const float tot = red[tl] + red[64 + tl];
            const float rn = rsqrtf(tot * (1.0f / 128.0f) + 1e-6f);
            const size_t row_ = (size_t)b * SEQ + c * 64 + tl;
#pragma unroll
            for (int et = 0; et < 4; ++et) { const int e0 = (eh * 4 + et) * 16 + fq * 4;
                const f32x4 nw = *(const f32x4*)(nwl + e0);
                f32x4 ogf; ogf[0] = bflo(og[et][0]); ogf[1] = bfhi(og[et][0]); ogf[2] = bflo(og[et][1]); ogf[3] = bfhi(og[et][1]);
                f32x4 o; for (int r = 0; r < 4; ++r) o[r] = acc[et][r] * rn * nw[r] * sigmoid_fast(ogf[r]);
                u32x2 w; w.x = pk2(o[0], o[1]); w.y = pk2(o[2], o[3]);
                *(u32x2*)(YC + row_ * 1024 + h * 128 + e0) = w; }
        }
        if (!own) {
#pragma unroll
            for (int dt = 0; dt < 4; ++dt)
#pragma unroll
                for (int r = 0; r < 4; ++r) CTs[(wid * 16 + fq * 4 + r) * 72 + dt * 16 + fr] = f2bf(accC[dt][r]);
            if (wid < 4) {
#pragma unroll
                for (int r = 0; r < 4; ++r) CTs[(128 + fq * 4 + r) * 72 + wid * 16 + fr] = f2bf(accCa[r]);
            }
        }
        if (c + 1 < SEQ / 64) ML_WRITE(c + 1);
        lds_barrier();
    }
#undef ML_LDX
#undef ML_LOAD
#undef ML_CONV
#undef ML_KOUT
#undef ML_WRITE
}

__device__ __forceinline__ void late_weights(KP p, const int wvs, const int bid, const int nb) {
    unsigned char* ws = p->ws;
    transpose_job(p->ab_w_out, (bf16_t*)(ws + WS_WT_ABO), 1024, 1024, 1024, wvs, bid, nb);
    transpose_job(p->mlp_w1, (bf16_t*)(ws + WS_WT_W1_0), 1024, 4096, 4096, wvs, bid, nb, p->norm_mlp_g);
    transpose_job(p->mlp_w2, (bf16_t*)(ws + WS_WT_W2_0), 4096, 1024, 1024, wvs, bid, nb);
    transpose_job(p->c_w_in, (bf16_t*)(ws + WS_WT_C), 1024, 3088, 3328, wvs, bid, nb, p->norm_mix_g + 1024);
    transpose_job(p->c_w_out, (bf16_t*)(ws + WS_WT_CO), 1024, 1024, 1024, wvs, bid, nb);
    transpose_job(p->mlp_w1 + (size_t)1024 * 4096, (bf16_t*)(ws + WS_WT_W1_1), 1024, 4096, 4096, wvs, bid, nb, p->norm_mlp_g + 1024);
    transpose_job(p->mlp_w2 + (size_t)1024 * 4096, (bf16_t*)(ws + WS_WT_W2_1), 4096, 1024, 1024, wvs, bid, nb);
}

#define XB_TMO      128
#define XB_XCNT(j)  (256  + 64 * (j))
#define XB_XSUB(j)  (1280 + 64 * (j))
#define XB_XGEN(j)  (2304 + 64 * (j))
#define XB_TOP      3328
#define XB_TOPGEN   3392
#define XB_SPIN_CAP (1u << 18)
typedef __attribute__((address_space(3))) unsigned lds_uword;
__device__ __forceinline__ unsigned xb_ld(unsigned* p)              { return __hip_atomic_load(p, __ATOMIC_RELAXED, __HIP_MEMORY_SCOPE_AGENT); }
__device__ __forceinline__ unsigned xb_add(unsigned* p, unsigned v) { return __hip_atomic_fetch_add(p, v, __ATOMIC_RELAXED, __HIP_MEMORY_SCOPE_AGENT); }
__device__ __forceinline__ unsigned xb_xcc_id() { return (unsigned)__builtin_amdgcn_s_getreg((3 << 11) | 20) & 0xFu; }
#define XB_SPIN(cond, bar) do { unsigned _sp = 0; while (cond) { __builtin_amdgcn_s_sleep(1); \
    if ((++_sp & 255u) == 0u) { if (xb_ld(&(bar)[XB_TMO])) break; if (_sp > XB_SPIN_CAP) { atomicAdd(&(bar)[XB_TMO], 1u); break; } } } } while (0)
struct XcdBarrier { unsigned* bar; unsigned x; volatile lds_uword* st; };
__device__ __forceinline__ void xcd_barrier_complete(unsigned* bar, unsigned x, unsigned& nloc, unsigned& nx) {
    const unsigned G = gridDim.x;
    unsigned sum, cnt, mine, sp = 0u;
    for (;;) {
        sum = 0u; cnt = 0u; mine = 0u;
#pragma unroll
        for (unsigned j = 0; j < 16; ++j) { const unsigned c = xb_ld(&bar[XB_XCNT(j)]); sum += c; cnt += (c > 0u) ? 1u : 0u; mine = (j == x) ? c : mine; }
        if (sum == G) break;
        __builtin_amdgcn_s_sleep(1);
        if ((++sp & 255u) == 0u) { if (xb_ld(&bar[XB_TMO])) break; if (sp > XB_SPIN_CAP) { atomicAdd(&bar[XB_TMO], 1u); break; } }
    }
    nloc = mine > 0u ? mine : 1u; nx = cnt > 0u ? cnt : 1u;
}
__device__ __forceinline__ void xcd_barrier(const XcdBarrier& b, const int wvs) {
    asm volatile("s_waitcnt vmcnt(0)" ::: "memory");
    __syncthreads();
    if (launder_tid(wvs) == 0) {
        unsigned* bar = b.bar;
        __builtin_amdgcn_s_waitcnt(0);
        unsigned nloc = b.st[0], nx = b.st[1];
        if (nloc == 0u) { xcd_barrier_complete(bar, b.x, nloc, nx); b.st[0] = nloc; b.st[1] = nx; }
        const unsigned old = xb_add(&bar[XB_XSUB(b.x)], 1u);
        const unsigned gen = old / nloc;
        if (old + 1u == (gen + 1u) * nloc) {
            __builtin_amdgcn_fence(__ATOMIC_RELEASE, "agent");
            asm volatile("s_waitcnt vmcnt(0)" ::: "memory");
            const unsigned og = xb_add(&bar[XB_TOP], 1u);
            const unsigned tg = og / nx;
            if (og + 1u == (tg + 1u) * nx) xb_add(&bar[XB_TOPGEN], 1u);
            else XB_SPIN(xb_ld(&bar[XB_TOPGEN]) == tg, bar);
            __builtin_amdgcn_fence(__ATOMIC_ACQUIRE, "agent");
            xb_add(&bar[XB_XGEN(b.x)], 1u);
            asm volatile("s_waitcnt vmcnt(0)" ::: "memory");
        } else {
            XB_SPIN(xb_ld(&bar[XB_XGEN(b.x)]) == gen, bar);
            __builtin_amdgcn_fence(__ATOMIC_ACQUIRE, "agent");
            asm volatile("s_waitcnt vmcnt(0)" ::: "memory");
        }
    }
    __syncthreads();
}

__global__ void __launch_bounds__(512) fwd_megakernel(const Params p_unused) {
    cg::grid_group grid = cg::this_grid();
    const KP kp0 = (KP)__builtin_amdgcn_kernarg_segment_ptr();
    const int wvs = __builtin_amdgcn_readfirstlane((int)(threadIdx.x >> 6));
    XcdBarrier xbar; xbar.bar = (unsigned*)(launder(kp0)->ws + WS_BAR); xbar.x = xb_xcc_id(); xbar.st = (volatile lds_uword*)(smem + GEMM_LDS);
    if (launder_tid(wvs) == 0) { xbar.st[0] = 0u; xbar.st[1] = 0u; (void)xb_add(&xbar.bar[XB_XCNT(xbar.x)], 1u); }
#define WSP (launder(kp0)->ws)
    prologue_phase(launder(kp0), wvs);
    grid.sync();
    { unsigned char* ws = WSP; gemm_phase<3840, 1024>((const bf16_t*)(ws + WS_H), (const bf16_t*)(ws + WS_WT_AB), EpiP0{(bf16_t*)(ws + WS_D_PRW), (bf16_t*)(ws + WS_C)}, wvs); }
    xcd_barrier(xbar, wvs);
    lora_in_phase(launder(kp0), wvs);
    xcd_barrier(xbar, wvs);
    { KP p = launder(kp0); unsigned char* ws = p->ws; gemm_phase<1536, 128, EpiLora, 256, true>((const bf16_t*)(ws + WS_D_L), (const bf16_t*)(ws + WS_WT_LORA),
               EpiLora{(bf16_t*)(ws + WS_D_W)}, wvs); }
    xcd_barrier(xbar, wvs);
    if (blockIdx.x < 128) rwkv_scan_unit(launder(kp0), blockIdx.x, wvs);
    else if (blockIdx.x < 192) retention_unit(launder(kp0), blockIdx.x - 128, wvs);
    else if (blockIdx.x < 256) late_weights(launder(kp0), wvs, blockIdx.x - 192, 64);
    xcd_barrier(xbar, wvs);
    { KP p = launder(kp0); unsigned char* ws = p->ws; gemm_phase<1024, 1024>((const bf16_t*)(ws + WS_H), (const bf16_t*)(ws + WS_WT_ABO), EpiResidIn{p->x, (bf16_t*)(ws + WS_C), (unsigned long long*)(ws + WS_R2)}, wvs); }
    xcd_barrier(xbar, wvs);
    { unsigned char* ws = WSP; gemm_phase<4096, 1024>((const bf16_t*)(ws + WS_C), (const bf16_t*)(ws + WS_WT_W1_0), EpiRelu2{(bf16_t*)(ws + WS_D), (const unsigned long long*)(ws + WS_R2)}, wvs); }
    xcd_barrier(xbar, wvs);
    { unsigned char* ws = WSP; gemm_phase<1024, 4096>((const bf16_t*)(ws + WS_D), (const bf16_t*)(ws + WS_WT_W2_0), EpiResidN{(bf16_t*)(ws + WS_C), (unsigned long long*)(ws + WS_R2) + MTOK}, wvs); }
    xcd_barrier(xbar, wvs);
    { unsigned char* ws = WSP; gemm_phase<3328, 1024>((const bf16_t*)(ws + WS_C), (const bf16_t*)(ws + WS_WT_C), EpiC{(bf16_t*)(ws + WS_D), (float*)(ws + WS_GATES), (const unsigned long long*)(ws + WS_R2) + MTOK}, wvs); }
    xcd_barrier(xbar, wvs);
    if (blockIdx.x < 256) mlstm_unit(launder(kp0), blockIdx.x, wvs);
    xcd_barrier(xbar, wvs);
    { unsigned char* ws = WSP; gemm_phase<1024, 1024>((const bf16_t*)(ws + WS_H), (const bf16_t*)(ws + WS_WT_CO), EpiResidN{(bf16_t*)(ws + WS_C), (unsigned long long*)(ws + WS_R2) + 2 * MTOK}, wvs); }
    xcd_barrier(xbar, wvs);
    { unsigned char* ws = WSP; gemm_phase<4096, 1024>((const bf16_t*)(ws + WS_C), (const bf16_t*)(ws + WS_WT_W1_1), EpiRelu2{(bf16_t*)(ws + WS_D), (const unsigned long long*)(ws + WS_R2) + 2 * MTOK}, wvs); }
    xcd_barrier(xbar, wvs);
    { unsigned char* ws = WSP; gemm_phase<1024, 4096>((const bf16_t*)(ws + WS_D), (const bf16_t*)(ws + WS_WT_W2_1), EpiResid{(bf16_t*)(ws + WS_C)}, wvs); }
    xcd_barrier(xbar, wvs);
    { KP p = launder(kp0); unsigned char* ws = p->ws; norm_phase_b((const bf16_t*)(ws + WS_C), p->norm_final_g, nullptr, p->out, wvs); }
#undef WSP
}

extern "C" void kernel_launch(void* const* d_in, const int* in_sizes, int n_in, void* d_out, int out_size, void* d_ws, size_t ws_size, hipStream_t stream) {
    constexpr int LDS_BYTES = GEMM_LDS + 64 + 1024;
    static int grid_blocks = 0;
    if (!grid_blocks) {
        int dev = 0, cus = 0, per_cu = 0;
        hipGetDevice(&dev);
        hipDeviceGetAttribute(&cus, hipDeviceAttributeMultiprocessorCount, dev);
        hipFuncSetAttribute((const void*)fwd_megakernel, hipFuncAttributeMaxDynamicSharedMemorySize, LDS_BYTES);
        hipOccupancyMaxActiveBlocksPerMultiprocessor(&per_cu, (const void*)fwd_megakernel, 512, LDS_BYTES);
        if (per_cu < 1) per_cu = 1;
        grid_blocks = cus;
        if (grid_blocks != 256) fprintf(stderr, "kernel_launch: expected 256 CUs, got %d\n", grid_blocks);
    }
    (void)hipMemsetAsync((unsigned char*)d_ws + WS_BAR, 0, WS_BAR_BYTES, stream);
    Params hp{};
    const float** pp = (const float**)&hp;
    for (int i = 0; i < 26; ++i) pp[i] = (const float*)d_in[i];
    hp.out = (float*)d_out; hp.ws = (unsigned char*)d_ws;
    void* args[] = {&hp};
    hipError_t e = hipLaunchCooperativeKernel((const void*)fwd_megakernel, dim3(grid_blocks), dim3(512), args, LDS_BYTES, stream);
    if (e != hipSuccess) fprintf(stderr, "cooperative launch failed: %s (grid %d)\n", hipGetErrorString(e), grid_blocks);
}
```

```cpp
#include <hip/hip_runtime.h>
#include <hip/hip_cooperative_groups.h>
#include <cstdint>
#include <cstdio>
namespace cg = cooperative_groups;

typedef unsigned short bf16_t;
typedef short bf16x8 __attribute__((ext_vector_type(8)));
typedef float f32x4 __attribute__((ext_vector_type(4)));
typedef unsigned u32x4 __attribute__((ext_vector_type(4)));
typedef unsigned u32x2 __attribute__((ext_vector_type(2)));

constexpr int MTOK = 65536, SEQ = 4096;
constexpr size_t MB = 1024 * 1024;
constexpr size_t WS_WT_AB = 0;
constexpr size_t WS_WT_ABO = WS_WT_AB + 3840 * 1024 * 2;
constexpr size_t WS_WT_W1_0 = WS_WT_ABO + 1024 * 1024 * 2;
constexpr size_t WS_WT_W2_0 = WS_WT_W1_0 + 4096 * 1024 * 2;
constexpr size_t WS_WT_C = WS_WT_W2_0 + 4096 * 1024 * 2;
constexpr size_t WS_WT_CO = WS_WT_C + 3328 * 1024 * 2;
constexpr size_t WS_WT_W1_1 = WS_WT_CO + 1024 * 1024 * 2;
constexpr size_t WS_WT_W2_1 = WS_WT_W1_1 + 4096 * 1024 * 2;
constexpr size_t WS_WT_LORA = WS_WT_W2_1 + 4096 * 1024 * 2;
constexpr size_t WS_COS = WS_WT_LORA + 1536 * 256 * 2;
constexpr size_t WS_SIN = WS_COS + 4096 * 64 * 4;
constexpr size_t WS_GATES = WS_SIN + 4096 * 64 * 4;
constexpr size_t WS_BAR = WS_GATES + (size_t)MTOK * 16 * 4;
constexpr size_t WS_BAR_BYTES = 16384;
constexpr size_t WS_R2 = WS_BAR + WS_BAR_BYTES;
constexpr size_t WS_A_END = WS_R2 + (size_t)3 * MTOK * 8;
static_assert(WS_A_END <= 60 * MB, "region A");
constexpr size_t WS_H = 60 * MB;
constexpr size_t WS_C = 188 * MB;
constexpr size_t WS_D = 444 * MB;
constexpr size_t WS_D_PRW = WS_D;
constexpr size_t WS_D_W = WS_D_PRW + (size_t)MTOK * 1792 * 2;
constexpr size_t WS_D_AG = WS_D_W + (size_t)MTOK * 512 * 2;
constexpr size_t WS_D_G = WS_D_AG + (size_t)MTOK * 512 * 2;
constexpr size_t WS_D_L = WS_D_G + (size_t)MTOK * 512 * 2;
static_assert(WS_D_L + (size_t)MTOK * 256 * 2 <= WS_D + 512 * MB, "region D");

struct Params {
    const float* x; const float* norm_mix_g; const float* norm_mlp_g; const float* norm_final_g;
    const float* ab_w_in; const float* rwkv_mu; const float* rwkv_w0; const float* rwkv_w_up; const float* rwkv_a0; const float* rwkv_a_up;
    const float* rwkv_g_up; const float* rwkv_k_k; const float* rwkv_k_a; const float* rwkv_r_k; const float* rwkv_ln_w; const float* rwkv_ln_b;
    const float* ab_w_out; const float* c_w_in; const float* c_conv_w; const float* c_conv_b; const float* c_i_bias; const float* c_f_bias;
    const float* c_norm_w; const float* c_w_out; const float* mlp_w1; const float* mlp_w2;
    float* out; unsigned char* ws;
};

typedef const Params __attribute__((address_space(4)))* KP;
__device__ __forceinline__ KP launder(KP p) { asm volatile("" : "+s"(p)); return p; }
__device__ __forceinline__ int launder_tid(const int wvs) { int l; asm volatile("v_mbcnt_lo_u32_b32 %0, -1, 0\n\tv_mbcnt_hi_u32_b32 %0, -1, %0" : "=v"(l)); return wvs * 64 + l; }
extern __shared__ __attribute__((aligned(16))) unsigned char smem[];

__device__ __forceinline__ unsigned pk2(float lo, float hi) { unsigned r; asm("v_cvt_pk_bf16_f32 %0, %1, %2" : "=v"(r) : "v"(lo), "v"(hi)); return r; }
__device__ __forceinline__ u32x4 pk8(const f32x4 a, const f32x4 b) { u32x4 w; w.x = pk2(a[0], a[1]); w.y = pk2(a[2], a[3]); w.z = pk2(b[0], b[1]); w.w = pk2(b[2], b[3]); return w; }
__device__ __forceinline__ bf16_t f2bf(float f) { return (bf16_t)(pk2(f, 0.f) & 0xffffu); }
__device__ __forceinline__ float bflo(unsigned u) { return __uint_as_float(u << 16); }
__device__ __forceinline__ float bfhi(unsigned u) { return __uint_as_float(u & 0xffff0000u); }
__device__ __forceinline__ float sigmoidf_(float z) { return 1.f / (1.f + __expf(-z)); }
__device__ __forceinline__ float sigmoid_fast(float z) { return __builtin_amdgcn_rcpf(1.f + __expf(-z)); }
template <int CTRL> __device__ __forceinline__ float dpp_add(float v) {
    return v + __builtin_bit_cast(float, __builtin_amdgcn_update_dpp(0, __builtin_bit_cast(int, v), CTRL, 0xf, 0xf, false));
}
__device__ __forceinline__ float red8(float v) { v = dpp_add<0xB1>(v); v = dpp_add<0x4E>(v); v = dpp_add<0x141>(v); return v; }
__device__ __forceinline__ float red16(float v) { v += __shfl_xor(v, 1); v += __shfl_xor(v, 2); v += __shfl_xor(v, 4); v += __shfl_xor(v, 8); return v; }
__device__ __forceinline__ float wave_sum(float v) { v = red16(v); v += __shfl_xor(v, 16); v += __shfl_xor(v, 32); return v; }

constexpr int BM = 256, BK = 64, HALF = 128, HT = HALF * BK, GEMM_LDS = 8 * HT * 2;
__device__ __forceinline__ int lds_byte(int r, int c) { int st = (r >> 4) * 2 + (c >> 5), rr = r & 15, cc = c & 31, ob = rr * 64 + cc * 2; return st * 1024 + (ob ^ (((ob >> 9) & 1) << 5)); }
__device__ __forceinline__ void stage_rc(int b, int& R, int& C) { int st = b / 1024, sb = b % 1024, swz = sb ^ (((sb >> 9) & 1) << 5); R = (st >> 1) * 16 + swz / 64; C = (st & 1) * 32 + (swz % 64) / 2; }

template <int N, int K, class Epi, int LD = K, bool KSEL = false, bool PADSKIP = false>
__device__ __forceinline__ void gemm_phase(const bf16_t* __restrict__ A, const bf16_t* __restrict__ Bt, const Epi epi, const int wvs) {
    typedef __attribute__((address_space(3))) unsigned char lds_u8;
    typedef __attribute__((address_space(3))) unsigned lds_u32;
    typedef __attribute__((address_space(3))) bf16x8 lds_bf16x8;
    lds_u8* lds = (lds_u8*)smem;
    constexpr int HTB = HALF * BK * 2;
    constexpr int nN = N / BM, ntiles = (MTOK / BM) * nN, nt = K / BK;
    const int tid = launder_tid(wvs), wid = wvs, lane = tid & 63, wr = wid >> 2, wc = wid & 3, fr = lane & 15, fq = lane >> 4;
    unsigned voff[2], voffB[2];
#pragma unroll
    for (int i = 0; i < 2; ++i) { int R, C; stage_rc(tid * 16 + i * 8192, R, C); voff[i] = (unsigned)(R * LD + C) * 2u;
        const int rho = R & 31, Rb = Epi::PERM ? ((R & ~31) + 8 * ((rho & 15) >> 2) + 4 * (rho >> 4) + (rho & 3)) : R; voffB[i] = (unsigned)(Rb * LD + C) * 2u; }
    constexpr size_t kstep = (size_t)(BK * 2), hstep = (size_t)HALF * LD * 2, tstep = 2 * hstep;
    const unsigned ldsw = (unsigned)wid * 1024u;
    const int aoff = lds_byte(wr * 64 + fr, fq * 8), boff = lds_byte(wc * 32 + fr, fq * 8);
#define PG8_SA(b, h) (((b) * 2 + (h)) * HTB)
#define PG8_SB(b, h) ((4 + (b) * 2 + (h)) * HTB)
#define PG8_STAGE(bufoff, gbase) PG8_STAGEV(bufoff, gbase, voff)
#define PG8_STAGEV(bufoff, gbase, vo_) do { _Pragma("unroll") for (int _i = 0; _i < 2; ++_i) \
        __builtin_amdgcn_global_load_lds((const unsigned*)((const char*)(gbase) + vo_[_i]), (lds_u32*)(lds + (bufoff) + ldsw + _i * 8192), 16, 0, 0); } while (0)
#define PG8_LDA(dst, b, h) do { _Pragma("unroll") for (int m = 0; m < 4; ++m) _Pragma("unroll") for (int k = 0; k < 2; ++k) dst[m][k] = *(const lds_bf16x8*)(lds + PG8_SA(b, h) + aoff + m * 2048 + k * 1024); } while (0)
#define PG8_LDB(dst, b, h) do { _Pragma("unroll") for (int n = 0; n < 2; ++n) _Pragma("unroll") for (int k = 0; k < 2; ++k) dst[n][k] = *(const lds_bf16x8*)(lds + PG8_SB(b, h) + boff + n * 2048 + k * 1024); } while (0)
#define PG8_MMA(ai, bj, At, Bt_) do { __builtin_amdgcn_s_setprio(1); _Pragma("unroll") for (int m = 0; m < 4; ++m) _Pragma("unroll") for (int n = 0; n < 2; ++n) _Pragma("unroll") for (int k = 0; k < 2; ++k) \
        acc[ai][bj][m][n] = __builtin_amdgcn_mfma_f32_16x16x32_bf16(Bt_[n][k], At[m][k], acc[ai][bj][m][n], 0, 0, 0); __builtin_amdgcn_s_setprio(0); } while (0)
#define PG8_WAIT_V(n) asm volatile("s_waitcnt vmcnt(" #n ")" ::: "memory")
#define PG8_WAIT_L(n) asm volatile("s_waitcnt lgkmcnt(" #n ")" ::: "memory")
#define PG8_BAR __builtin_amdgcn_s_barrier()
#define PG8_SCHED __builtin_amdgcn_sched_barrier(0)
#define PG8_TILE(t_, pm_, pn_) do { const int w_ = ((t_) & 7) * (ntiles / 8) + ((t_) >> 3); const int g_ = w_ / (8 * nN), r_ = w_ - g_ * (8 * nN); pm_ = g_ * 8 + (r_ & 7); pn_ = r_ >> 3; } while (0)
    int tile = blockIdx.x;
    if (tile >= ntiles) return;
    int cpm, cpn; PG8_TILE(tile, cpm, cpn);
    f32x4 acc[2][2][4][2];
#pragma unroll
    for (int a_ = 0; a_ < 2; ++a_)
#pragma unroll
        for (int b_ = 0; b_ < 2; ++b_)
#pragma unroll
            for (int m = 0; m < 4; ++m)
#pragma unroll
                for (int n = 0; n < 2; ++n) acc[a_][b_][m][n] = (f32x4){0.f, 0.f, 0.f, 0.f};
    bf16x8 At[4][2], B0[2][2], B1[2][2];
    const char* cA = (const char*)A + (size_t)cpm * tstep + (KSEL && cpn >= 4 ? 256 : 0); const char* cB = (const char*)Bt + (size_t)cpn * tstep + (KSEL && cpn >= 4 ? 256 : 0);
    PG8_STAGEV(PG8_SB(0, 0), cB, voffB); PG8_STAGEV(PG8_SB(0, 1), cB + hstep, voffB); PG8_STAGE(PG8_SA(0, 0), cA); PG8_STAGE(PG8_SA(0, 1), cA + hstep);
    if (wr == 1) PG8_BAR;
    PG8_WAIT_V(2); PG8_BAR;
    PG8_STAGEV(PG8_SB(1, 0), cB + kstep, voffB); PG8_STAGE(PG8_SA(1, 0), cA + kstep); PG8_STAGEV(PG8_SB(1, 1), cB + hstep + kstep, voffB);
    PG8_WAIT_V(6); PG8_BAR;
    for (;;) {
        const int ntile = tile + gridDim.x; const bool has_next = ntile < ntiles;
        int npm = cpm, npn = cpn; if (has_next) PG8_TILE(ntile, npm, npn);
        const char* nA = (const char*)A + (size_t)npm * tstep + (KSEL && npn >= 4 ? 256 : 0); const char* nB = (const char*)Bt + (size_t)npn * tstep + (KSEL && npn >= 4 ? 256 : 0);
        for (int t = 0; t < nt; t += 2) {
            const bool last = (t == nt - 2);
            const char* a1 = cA + (size_t)(t + 1) * kstep;
            const char* a2 = last ? nA : cA + (size_t)(t + 2) * kstep; const char* b2 = last ? nB : cB + (size_t)(t + 2) * kstep;
            const char* a3 = a2 + kstep; const char* b3 = b2 + kstep;
            PG8_LDB(B0, 0, 0); PG8_LDB(B1, 0, 1); PG8_SCHED; PG8_LDA(At, 0, 0); PG8_STAGE(PG8_SA(1, 1), a1 + hstep);
            PG8_WAIT_V(8); PG8_WAIT_L(0); PG8_BAR; PG8_MMA(0, 0, At, B0); if (!(PADSKIP && cpn == nN - 1)) PG8_MMA(0, 1, At, B1); PG8_BAR; PG8_SCHED;
            PG8_LDA(At, 0, 1); PG8_STAGEV(PG8_SB(0, 0), b2, voffB); PG8_STAGEV(PG8_SB(0, 1), b2 + hstep, voffB); PG8_STAGE(PG8_SA(0, 0), a2);
            PG8_WAIT_V(8); PG8_WAIT_L(0); PG8_BAR; PG8_MMA(1, 0, At, B0); if (!(PADSKIP && cpn == nN - 1)) PG8_MMA(1, 1, At, B1); PG8_BAR; PG8_SCHED;
            PG8_LDB(B0, 1, 0); PG8_LDB(B1, 1, 1); PG8_SCHED; PG8_LDA(At, 1, 0); PG8_STAGE(PG8_SA(0, 1), a2 + hstep);
            PG8_WAIT_V(8); PG8_WAIT_L(0); PG8_BAR; PG8_MMA(0, 0, At, B0); if (!(PADSKIP && cpn == nN - 1)) PG8_MMA(0, 1, At, B1); PG8_BAR; PG8_SCHED;
            PG8_LDA(At, 1, 1); PG8_STAGEV(PG8_SB(1, 0), b3, voffB); PG8_STAGEV(PG8_SB(1, 1), b3 + hstep, voffB); PG8_STAGE(PG8_SA(1, 0), a3);
            PG8_WAIT_V(8); PG8_WAIT_L(0); PG8_BAR; PG8_MMA(1, 0, At, B0); if (!(PADSKIP && cpn == nN - 1)) PG8_MMA(1, 1, At, B1); PG8_BAR; PG8_SCHED;
        }
        if (wr == 0) PG8_BAR;
        {
            const int tid_e = launder_tid(wvs), wr_e = (tid_e >> 8) & 1, wc_e = (tid_e >> 6) & 3, fr_e = tid_e & 15, fq_e = (tid_e >> 4) & 3;
            const int brow = cpm * BM, bcol = cpn * BM; float rowss = 0.f; (void)rowss;
            volatile __attribute__((address_space(3))) float* rsL = (volatile __attribute__((address_space(3))) float*)(lds + GEMM_LDS + 64);
            if constexpr (Epi::ROWSCALE) {
                if (tid_e < 256) rsL[tid_e] = epi.rowscale(brow + tid_e);
                PG8_WAIT_L(0); PG8_BAR; asm volatile("" ::: "memory");
            }
#pragma unroll
            for (int ai = 0; ai < 2; ++ai)
#pragma unroll
                for (int m = 0; m < 4; ++m)
#pragma unroll
                    for (int bj = 0; bj < 2; ++bj) {
                        if constexpr (Epi::ROWSCALE) epi.op8s(brow + ai * HALF + wr_e * 64 + m * 16 + fr_e, bcol + bj * HALF + wc_e * 32 + fq_e * 8, acc[ai][bj][m][0], acc[ai][bj][m][1], rsL[ai * HALF + wr_e * 64 + m * 16 + fr_e]);
                        else if constexpr (Epi::ROWSS) { const float ss_ = epi.op8r(brow + ai * HALF + wr_e * 64 + m * 16 + fr_e, bcol + bj * HALF + wc_e * 32 + fq_e * 8, acc[ai][bj][m][0], acc[ai][bj][m][1]);
                            if (bj == 0) rowss = ss_; else epi.rowdone(brow + ai * HALF + wr_e * 64 + m * 16 + fr_e, rowss + ss_, fq_e); }
                        else if constexpr (Epi::PERM) epi.op8(brow + ai * HALF + wr_e * 64 + m * 16 + fr_e, bcol + bj * HALF + wc_e * 32 + fq_e * 8, acc[ai][bj][m][0], acc[ai][bj][m][1]);
                        else {
#pragma unroll
                            for (int n = 0; n < 2; ++n)
                                epi(brow + ai * HALF + wr_e * 64 + m * 16 + fr_e, bcol + bj * HALF + wc_e * 32 + n * 16 + fq_e * 4, acc[ai][bj][m][n]);
                        }
                    }
        }
        if (!has_next) break;
#pragma unroll
        for (int a_ = 0; a_ < 2; ++a_)
#pragma unroll
            for (int b_ = 0; b_ < 2; ++b_)
#pragma unroll
                for (int m = 0; m < 4; ++m)
#pragma unroll
                    for (int n = 0; n < 2; ++n) acc[a_][b_][m][n] = (f32x4){0.f, 0.f, 0.f, 0.f};
        tile = ntile; cpm = npm; cpn = npn; cA = nA; cB = nB;
        if (wr == 1) PG8_BAR;
    }
    PG8_WAIT_V(0);
    PG8_BAR;
#undef PG8_SA
#undef PG8_SB
#undef PG8_STAGE
#undef PG8_STAGEV
#undef PG8_LDA
#undef PG8_LDB
#undef PG8_MMA
#undef PG8_WAIT_V
#undef PG8_WAIT_L
#undef PG8_BAR
#undef PG8_SCHED
#undef PG8_TILE
}

struct EpiP0 { static constexpr bool PERM = true; static constexpr bool ROWSCALE = false; static constexpr bool ROWSS = false; bf16_t* prw; bf16_t* pret;
    __device__ __forceinline__ void op8(int row, int col, f32x4 v0, f32x4 v1) const {
        const u32x4 w = pk8(v0, v1);
        if (col < 1792) __builtin_nontemporal_store(w, (u32x4*)(prw + (size_t)row * 1792 + col)); else __builtin_nontemporal_store(w, (u32x4*)(pret + (size_t)row * 2048 + (col - 1792))); } };
struct EpiLora { static constexpr bool PERM = true; static constexpr bool ROWSCALE = false; static constexpr bool ROWSS = false; bf16_t* base;
    __device__ __forceinline__ void op8(int row, int col, f32x4 v0, f32x4 v1) const {
        *(u32x4*)(base + (size_t)(col >> 9) * ((size_t)MTOK * 512) + (size_t)row * 512 + (col & 511)) = pk8(v0, v1); } };
__device__ __forceinline__ float sumsq8(const f32x4 a, const f32x4 b) { return ((a[0] * a[0] + a[1] * a[1]) + (a[2] * a[2] + a[3] * a[3])) + ((b[0] * b[0] + b[1] * b[1]) + (b[2] * b[2] + b[3] * b[3])); }
struct EpiResidIn { static constexpr bool PERM = true; static constexpr bool ROWSCALE = false; static constexpr bool ROWSS = true; const float* xin; bf16_t* xout; unsigned long long* r2;
    __device__ __forceinline__ float op8r(int row, int col, f32x4 v0, f32x4 v1) const {
        const float* xi = xin + (size_t)row * 1024 + col;
        const f32x4 x0 = *(const f32x4*)xi + v0, x1 = *(const f32x4*)(xi + 4) + v1; *(u32x4*)(xout + (size_t)row * 1024 + col) = pk8(x0, x1);
        return sumsq8(x0, x1); }
    __device__ __forceinline__ void rowdone(int row, float ss, int fq) const { ss += __shfl_xor(ss, 16); ss += __shfl_xor(ss, 32); if (fq == 0) atomicAdd(r2 + row, (unsigned long long)(ss * 1048576.0f + 0.5f)); } };
struct EpiResidN { static constexpr bool PERM = true; static constexpr bool ROWSCALE = false; static constexpr bool ROWSS = true; bf16_t* x; unsigned long long* r2;
    __device__ __forceinline__ float op8r(int row, int col, f32x4 v0, f32x4 v1) const {
        bf16_t* xp = x + (size_t)row * 1024 + col; const u32x4 r = *(const u32x4*)xp;
        f32x4 r0, r1; r0[0] = bflo(r[0]); r0[1] = bfhi(r[0]); r0[2] = bflo(r[1]); r0[3] = bfhi(r[1]); r1[0] = bflo(r[2]); r1[1] = bfhi(r[2]); r1[2] = bflo(r[3]); r1[3] = bfhi(r[3]);
        const f32x4 x0 = r0 + v0, x1 = r1 + v1; *(u32x4*)xp = pk8(x0, x1);
        return sumsq8(x0, x1); }
    __device__ __forceinline__ void rowdone(int row, float ss, int fq) const { ss += __shfl_xor(ss, 16); ss += __shfl_xor(ss, 32); if (fq == 0) atomicAdd(r2 + row, (unsigned long long)(ss * 1048576.0f + 0.5f)); } };
struct EpiResid { static constexpr bool PERM = true; static constexpr bool ROWSCALE = false; static constexpr bool ROWSS = false; bf16_t* x;
    __device__ __forceinline__ void op8(int row, int col, f32x4 v0, f32x4 v1) const {
        bf16_t* xp = x + (size_t)row * 1024 + col; const u32x4 r = *(const u32x4*)xp;
        f32x4 r0, r1; r0[0] = bflo(r[0]); r0[1] = bfhi(r[0]); r0[2] = bflo(r[1]); r0[3] = bfhi(r[1]); r1[0] = bflo(r[2]); r1[1] = bfhi(r[2]); r1[2] = bflo(r[3]); r1[3] = bfhi(r[3]);
        *(u32x4*)xp = pk8(r0 + v0, r1 + v1); } };
struct EpiRelu2 { static constexpr bool PERM = true; static constexpr bool ROWSS = false; static constexpr bool ROWSCALE = true; bf16_t* hid; const unsigned long long* r2;
    __device__ __forceinline__ float rowscale(int row) const { return __builtin_amdgcn_rcpf((float)r2[row] * (1.0f / (1024.0f * 1048576.0f)) + 1e-6f); }
    __device__ __forceinline__ void op8s(int row, int col, f32x4 v0, f32x4 v1, float rs2) const {
        f32x4 t0, t1; for (int i = 0; i < 4; ++i) { const float r0 = fmaxf(v0[i], 0.f), r1 = fmaxf(v1[i], 0.f); t0[i] = r0 * r0 * rs2; t1[i] = r1 * r1 * rs2; }
        __builtin_nontemporal_store(pk8(t0, t1), (u32x4*)(hid + (size_t)row * 4096 + col)); } };
struct EpiC { static constexpr bool PERM = true; static constexpr bool ROWSS = false; static constexpr bool ROWSCALE = true; bf16_t* pc; float* gates; const unsigned long long* r2;
    __device__ __forceinline__ float rowscale(int row) const { return rsqrtf((float)r2[row] * (1.0f / (1024.0f * 1048576.0f)) + 1e-6f); }
    __device__ __forceinline__ void op8s(int row, int col, f32x4 v0, f32x4 v1, float rs) const {
        v0 = v0 * rs; v1 = v1 * rs;
        if (col < 3072) __builtin_nontemporal_store(pk8(v0, v1), (u32x4*)(pc + (size_t)row * 3072 + col));
        else if (col < 3088) { float* gp = gates + (size_t)row * 16 + (col - 3072); *(f32x4*)gp = v0; *(f32x4*)(gp + 4) = v1; } } };

__device__ __forceinline__ void transpose_job(const float* __restrict__ src, bf16_t* __restrict__ dst, const int K, const int N, const int Npad, const int wvs, const int bid, const int nb, const float* __restrict__ gk = nullptr) {
    float* tile = (float*)smem;
    const int nkt = K / 64, nnt = Npad / 64, tid = launder_tid(wvs);
    for (int t = bid; t < nkt * nnt; t += nb) {
        const int kt = t % nkt, ntl = t / nkt, k0 = kt * 64, n0 = ntl * 64;
        const int r = tid >> 4, c4 = (tid & 15) * 4;
#pragma unroll
        for (int p = 0; p < 2; ++p) { const int k = r + p * 32; f32x4 v = {0.f, 0.f, 0.f, 0.f};
            if (n0 + c4 < N) v = *(const f32x4*)(src + (size_t)(k0 + k) * N + n0 + c4);
            if (gk) v = v * gk[k0 + k];
            tile[k * 65 + c4 + 0] = v[0]; tile[k * 65 + c4 + 1] = v[1]; tile[k * 65 + c4 + 2] = v[2]; tile[k * 65 + c4 + 3] = v[3]; }
        __syncthreads();
        const int n = tid >> 3, k8 = (tid & 7) * 8;
        const float* s = tile + k8 * 65 + n;
        u32x4 o; o.x = pk2(s[0], s[65]); o.y = pk2(s[2 * 65], s[3 * 65]); o.z = pk2(s[4 * 65], s[5 * 65]); o.w = pk2(s[6 * 65], s[7 * 65]);
        *(u32x4*)(dst + (size_t)(n0 + n) * K + k0 + k8) = o;
        __syncthreads();
    }
}

__device__ __forceinline__ void norm_phase(const float* __restrict__ X, const float* __restrict__ g, bf16_t* __restrict__ Hout, float* __restrict__ Fout, const int wvs) {
    const int tid = launder_tid(wvs);
    const int wid = tid >> 6, lane = tid & 63;
    f32x4 gv[4];
#pragma unroll
    for (int j = 0; j < 4; ++j) gv[j] = *(const f32x4*)(g + lane * 4 + j * 256);
    for (int row = blockIdx.x * 8 + wid; row < MTOK; row += gridDim.x * 8) {
        const float* xr = X + (size_t)row * 1024 + lane * 4;
        f32x4 v[4]; float s = 0.f;
#pragma unroll
        for (int j = 0; j < 4; ++j) { v[j] = *(const f32x4*)(xr + j * 256); s += (v[j][0] * v[j][0] + v[j][1] * v[j][1]) + (v[j][2] * v[j][2] + v[j][3] * v[j][3]); }
        s = wave_sum(s);
        const float rs = rsqrtf(s * (1.0f / 1024.0f) + 1e-6f);
#pragma unroll
        for (int j = 0; j < 4; ++j) { const f32x4 o = v[j] * rs * gv[j];
            if (Hout) { u32x2 w; w.x = pk2(o[0], o[1]); w.y = pk2(o[2], o[3]); *(u32x2*)(Hout + (size_t)row * 1024 + lane * 4 + j * 256) = w; }
            else *(f32x4*)(Fout + (size_t)row * 1024 + lane * 4 + j * 256) = o; }
    }
}

__device__ __forceinline__ void norm_phase_b(const bf16_t* __restrict__ X, const float* __restrict__ g, bf16_t* __restrict__ Hout, float* __restrict__ Fout, const int wvs) {
    const int tid = launder_tid(wvs);
    const int wid = tid >> 6, lane = tid & 63;
    f32x4 gv[4];
#pragma unroll
    for (int j = 0; j < 2; ++j) { gv[2 * j] = *(const f32x4*)(g + lane * 8 + j * 512); gv[2 * j + 1] = *(const f32x4*)(g + lane * 8 + j * 512 + 4); }
    for (int row = blockIdx.x * 8 + wid; row < MTOK; row += gridDim.x * 8) {
        const bf16_t* xr = X + (size_t)row * 1024 + lane * 8;
        f32x4 v[4]; float s = 0.f;
#pragma unroll
        for (int j = 0; j < 2; ++j) { const u32x4 r = *(const u32x4*)(xr + j * 512);
            v[2 * j][0] = bflo(r[0]); v[2 * j][1] = bfhi(r[0]); v[2 * j][2] = bflo(r[1]); v[2 * j][3] = bfhi(r[1]);
            v[2 * j + 1][0] = bflo(r[2]); v[2 * j + 1][1] = bfhi(r[2]); v[2 * j + 1][2] = bflo(r[3]); v[2 * j + 1][3] = bfhi(r[3]); }
#pragma unroll
        for (int j = 0; j < 4; ++j) s += (v[j][0] * v[j][0] + v[j][1] * v[j][1]) + (v[j][2] * v[j][2] + v[j][3] * v[j][3]);
        s = wave_sum(s);
        const float rs = rsqrtf(s * (1.0f / 1024.0f) + 1e-6f);
#pragma unroll
        for (int j = 0; j < 2; ++j) { const f32x4 o0 = v[2 * j] * rs * gv[2 * j], o1 = v[2 * j + 1] * rs * gv[2 * j + 1];
            if (Hout) *(u32x4*)(Hout + (size_t)row * 1024 + lane * 8 + j * 512) = pk8(o0, o1);
            else { float* fo = Fout + (size_t)row * 1024 + lane * 8 + j * 512; *(f32x4*)fo = o0; *(f32x4*)(fo + 4) = o1; } }
    }
}

__device__ __forceinline__ void prologue_phase(KP p, const int wvs) {
    unsigned char* ws = p->ws;
    transpose_job(p->ab_w_in, (bf16_t*)(ws + WS_WT_AB), 1024, 3840, 3840, wvs, blockIdx.x, gridDim.x);
    const int gtid = blockIdx.x * 512 + launder_tid(wvs), gsz = gridDim.x * 512;
    bf16_t* wl = (bf16_t*)(ws + WS_WT_LORA);
    for (int idx = gtid; idx < 1536 * 256; idx += gsz) {
        const int n = idx >> 8, k = idx & 255; float v = 0.f;
        if (n < 512) { if (k < 64) v = p->rwkv_w_up[k * 512 + n]; }
        else if (n < 1024) { if (k >= 64 && k < 128) v = p->rwkv_a_up[(k - 64) * 512 + (n - 512)]; }
        else { if (k >= 128) v = p->rwkv_g_up[(k - 128) * 512 + (n - 1024)]; }
        wl[idx] = f2bf(v);
    }
    float* ct = (float*)(ws + WS_COS); float* stb = (float*)(ws + WS_SIN);
    for (int idx = gtid; idx < 4096 * 64; idx += gsz) {
        const int pos = idx >> 6, i = idx & 63;
        const float inv = powf(10000.0f, -(float)(2 * i) / 128.0f);
        const float ang = (float)pos * inv;
        double rev = (double)ang * 0.15915494309189535; rev -= __builtin_rint(rev);
        ct[idx] = __builtin_amdgcn_cosf((float)rev); stb[idx] = __builtin_amdgcn_sinf((float)rev);
    }
    { unsigned long long* r2 = (unsigned long long*)(ws + WS_R2); for (int idx = gtid; idx < 3 * MTOK; idx += gsz) r2[idx] = 0ull; }
    norm_phase(p->x, p->norm_mix_g, (bf16_t*)(ws + WS_H), nullptr, wvs);
}

__device__ __forceinline__ void lora_in_phase(KP p, const int wvs) {
    const bf16_t* prw = (const bf16_t*)(p->ws + WS_D_PRW); bf16_t* L = (bf16_t*)(p->ws + WS_D_L);
    const int gtid = blockIdx.x * 512 + launder_tid(wvs), gsz = gridDim.x * 512;
    for (int item = gtid; item < MTOK * 32; item += gsz) {
        const int row = item >> 5, c8 = (item & 31) * 8;
        const u32x4 cur = *(const u32x4*)(prw + (size_t)row * 1792 + 1536 + c8);
        u32x4 prv = {0u, 0u, 0u, 0u};
        if ((row & (SEQ - 1)) != 0) prv = *(const u32x4*)(prw + (size_t)(row - 1) * 1792 + 1536 + c8);
        const f32x4 m0 = *(const f32x4*)(p->rwkv_mu + 1536 + c8), m1 = *(const f32x4*)(p->rwkv_mu + 1536 + c8 + 4);
        float v[8];
#pragma unroll
        for (int i = 0; i < 4; ++i) {
            const float c0 = bflo(cur[i]), c1 = bfhi(cur[i]), p0 = bflo(prv[i]), p1 = bfhi(prv[i]);
            const float mu0 = (i < 2) ? m0[2 * i] : m1[2 * i - 4], mu1 = (i < 2) ? m0[2 * i + 1] : m1[2 * i - 3];
            v[2 * i] = c0 + (p0 - c0) * mu0; v[2 * i + 1] = c1 + (p1 - c1) * mu1;
        }
        if (c8 < 64) {
#pragma unroll
            for (int i = 0; i < 8; ++i) { const float e = __expf(2.f * v[i]); v[i] = 1.f - 2.f * __builtin_amdgcn_rcpf(e + 1.f); }
        } else if (c8 >= 128) {
#pragma unroll
            for (int i = 0; i < 8; ++i) v[i] = __builtin_amdgcn_rcpf(1.f + __expf(-v[i]));
        }
        u32x4 o; o.x = pk2(v[0], v[1]); o.y = pk2(v[2], v[3]); o.z = pk2(v[4], v[5]); o.w = pk2(v[6], v[7]);
        *(u32x4*)(L + (size_t)row * 256 + c8) = o;
    }
}

__device__ __forceinline__ void lds_barrier() { asm volatile("s_waitcnt lgkmcnt(0)" ::: "memory"); __builtin_amdgcn_s_barrier(); asm volatile("" ::: "memory"); }
typedef float f32x2 __attribute__((ext_vector_type(2)));
__device__ __forceinline__ void rwkv_scan_unit(KP p, const int unit, const int wvs) {
    const int b = unit >> 3, h = unit & 7;
    const int tid = launder_tid(wvs), wid = tid >> 6, lane = tid & 63;
    constexpr int TC = 16, NC = SEQ / TC;
    float* bufs = (float*)smem;
    float* yl = bufs + 2 * TC * 384;
    if (__builtin_amdgcn_readfirstlane(wid) < 4) {
        const int il = lane >> 3, jg = lane & 7, i0 = wid * 16 + il, i1 = i0 + 8;
        f32x2 A0 = {0.f, 0.f}, A1 = A0, A2 = A0, A3 = A0, B0 = A0, B1 = A0, B2 = A0, B3 = A0;
#define SC_LOAD(S, t_) do { const float* sn_ = sp + (t_) * 384; \
        a0##S = *(const f32x4*)(sn_); a1##S = *(const f32x4*)(sn_ + 4); w0##S = *(const f32x4*)(sn_ + 64); w1##S = *(const f32x4*)(sn_ + 68); \
        b0##S = *(const f32x4*)(sn_ + 128); b1##S = *(const f32x4*)(sn_ + 132); k0##S = *(const f32x4*)(sn_ + 192); k1##S = *(const f32x4*)(sn_ + 196); \
        r0##S = *(const f32x4*)(sn_ + 256); r1##S = *(const f32x4*)(sn_ + 260); v0##S = buf[(t_) * 384 + 320 + i0]; v1##S = buf[(t_) * 384 + 320 + i1]; } while (0)
#define SC_STEP(S, t_) do { \
        f32x2 ta = A0 * a0##S.xy; ta = A1 * a0##S.zw + ta; ta = A2 * a1##S.xy + ta; ta = A3 * a1##S.zw + ta; \
        f32x2 tb = B0 * a0##S.xy; tb = B1 * a0##S.zw + tb; tb = B2 * a1##S.xy + tb; tb = B3 * a1##S.zw + tb; \
        float sa = ta.x + ta.y, sb = tb.x + tb.y; sa = red8(sa); sb = red8(sb); \
        const f32x2 sa2 = {sa, sa}, sb2 = {sb, sb}, va2 = {v0##S, v0##S}, vb2 = {v1##S, v1##S}; \
        A0 = A0 * w0##S.xy + (sa2 * b0##S.xy + va2 * k0##S.xy); A1 = A1 * w0##S.zw + (sa2 * b0##S.zw + va2 * k0##S.zw); \
        A2 = A2 * w1##S.xy + (sa2 * b1##S.xy + va2 * k1##S.xy); A3 = A3 * w1##S.zw + (sa2 * b1##S.zw + va2 * k1##S.zw); \
        B0 = B0 * w0##S.xy + (sb2 * b0##S.xy + vb2 * k0##S.xy); B1 = B1 * w0##S.zw + (sb2 * b0##S.zw + vb2 * k0##S.zw); \
        B2 = B2 * w1##S.xy + (sb2 * b1##S.xy + vb2 * k1##S.xy); B3 = B3 * w1##S.zw + (sb2 * b1##S.zw + vb2 * k1##S.zw); \
        f32x2 ua = A0 * r0##S.xy; ua = A1 * r0##S.zw + ua; ua = A2 * r1##S.xy + ua; ua = A3 * r1##S.zw + ua; \
        f32x2 ub = B0 * r0##S.xy; ub = B1 * r0##S.zw + ub; ub = B2 * r1##S.xy + ub; ub = B3 * r1##S.zw + ub; \
        yb[(t_) * 512 + i0 * 8 + jg] = ua.x + ua.y; yb[(t_) * 512 + i1 * 8 + jg] = ub.x + ub.y; } while (0)
        lds_barrier();
        for (int c = 0; c < NC; ++c) {
            const float* buf = bufs + (c & 1) * (TC * 384);
            float* yb = yl + (c & 1) * (TC * 512);
            const float* sp = buf + jg * 8;
            f32x4 a0X, a1X, w0X, w1X, b0X, b1X, k0X, k1X, r0X, r1X, a0Y, a1Y, w0Y, w1Y, b0Y, b1Y, k0Y, k1Y, r0Y, r1Y; float v0X, v1X, v0Y, v1Y;
            SC_LOAD(X, 0);
#pragma unroll
            for (int t = 0; t < TC; t += 2) {
                SC_LOAD(Y, t + 1);
                SC_STEP(X, t);
                if (t + 2 < TC) SC_LOAD(X, t + 2);
                SC_STEP(Y, t + 1);
            }
            lds_barrier();
        }
        lds_barrier();
#undef SC_LOAD
#undef SC_STEP
    } else {
        const bf16_t* prw = (const bf16_t*)(p->ws + WS_D_PRW);
        const bf16_t* Wb = (const bf16_t*)(p->ws + WS_D_W);
        const bf16_t* AGb = (const bf16_t*)(p->ws + WS_D_AG);
        const bf16_t* Gb = (const bf16_t*)(p->ws + WS_D_G);
        bf16_t* YC = (bf16_t*)(p->ws + WS_H);
        const int ptid = tid - 256, st = ptid >> 4, sc = (ptid & 15) * 4, ch = h * 64 + sc;
        const f32x4 mu_r = *(const f32x4*)(p->rwkv_mu + ch), mu_k = *(const f32x4*)(p->rwkv_mu + 512 + ch), mu_v = *(const f32x4*)(p->rwkv_mu + 1024 + ch);
        const f32x4 kkc = *(const f32x4*)(p->rwkv_k_k + ch), kac = *(const f32x4*)(p->rwkv_k_a + ch), rkc = *(const f32x4*)(p->rwkv_r_k + ch);
        const f32x4 lnw = *(const f32x4*)(p->rwkv_ln_w + ch), lnb = *(const f32x4*)(p->rwkv_ln_b + ch);
        const f32x4 w0c = *(const f32x4*)(p->rwkv_w0 + ch), a0c = *(const f32x4*)(p->rwkv_a0 + ch);
        u32x2 r_c, r_p, k_c, k_p, v_c, v_p, w_r, ag_r, g_r;
#define RW_LOAD(c) do { const int t_ = (c) * TC + st; const size_t row_ = (size_t)b * SEQ + t_; const bf16_t* pr_ = prw + row_ * 1792 + ch; \
        r_c = *(const u32x2*)(pr_); k_c = *(const u32x2*)(pr_ + 512); v_c = *(const u32x2*)(pr_ + 1024); \
        if (t_ > 0) { r_p = *(const u32x2*)(pr_ - 1792); k_p = *(const u32x2*)(pr_ - 1792 + 512); v_p = *(const u32x2*)(pr_ - 1792 + 1024); } \
        else { r_p = (u32x2){0u, 0u}; k_p = r_p; v_p = r_p; } \
        w_r = *(const u32x2*)(Wb + row_ * 512 + ch); ag_r = *(const u32x2*)(AGb + row_ * 512 + ch); } while (0)
#define RW_WRITE(buf) do { float* d_ = (buf) + st * 384 + sc; \
        f32x4 rr_, kk_, vv_, ag_, ew_; \
        for (int e = 0; e < 2; ++e) { \
            { const float c0 = bflo(r_c[e]), c1 = bfhi(r_c[e]), p0 = bflo(r_p[e]), p1 = bfhi(r_p[e]); rr_[2 * e] = c0 + (p0 - c0) * mu_r[2 * e]; rr_[2 * e + 1] = c1 + (p1 - c1) * mu_r[2 * e + 1]; } \
            { const float c0 = bflo(k_c[e]), c1 = bfhi(k_c[e]), p0 = bflo(k_p[e]), p1 = bfhi(k_p[e]); kk_[2 * e] = c0 + (p0 - c0) * mu_k[2 * e]; kk_[2 * e + 1] = c1 + (p1 - c1) * mu_k[2 * e + 1]; } \
            { const float c0 = bflo(v_c[e]), c1 = bfhi(v_c[e]), p0 = bflo(v_p[e]), p1 = bfhi(v_p[e]); vv_[2 * e] = c0 + (p0 - c0) * mu_v[2 * e]; vv_[2 * e + 1] = c1 + (p1 - c1) * mu_v[2 * e + 1]; } \
            ag_[2 * e] = sigmoid_fast(bflo(ag_r[e]) + a0c[2 * e]); ag_[2 * e + 1] = sigmoid_fast(bfhi(ag_r[e]) + a0c[2 * e + 1]); \
            ew_[2 * e] = 0.60653066f * sigmoid_fast(bflo(w_r[e]) + w0c[2 * e]); ew_[2 * e + 1] = 0.60653066f * sigmoid_fast(bfhi(w_r[e]) + w0c[2 * e + 1]); } \
        const f32x4 kn_ = kk_ * kkc; float ss_ = (kn_[0] * kn_[0] + kn_[1] * kn_[1]) + (kn_[2] * kn_[2] + kn_[3] * kn_[3]); ss_ = red16(ss_); \
        const float rn_ = rsqrtf(fmaxf(ss_, 1e-24f)); const f32x4 kkn_ = kn_ * rn_; \
        f32x4 dec_; for (int e = 0; e < 4; ++e) dec_[e] = __expf(-ew_[e]); \
        *(f32x4*)(d_) = -kkn_; *(f32x4*)(d_ + 64) = dec_; *(f32x4*)(d_ + 128) = kkn_ * ag_; \
        *(f32x4*)(d_ + 192) = kk_ * (1.0f + (ag_ - 1.0f) * kac); *(f32x4*)(d_ + 256) = rr_; *(f32x4*)(d_ + 320) = vv_; } while (0)
#define RW_POST(c) do { const float* buf_ = bufs + ((c) & 1) * (TC * 384); const float* yp_ = yl + ((c) & 1) * (TC * 512) + st * 512 + sc * 8; \
            f32x4 y4; \
            for (int e = 0; e < 4; ++e) { const f32x4 q0 = *(const f32x4*)(yp_ + e * 8), q1 = *(const f32x4*)(yp_ + e * 8 + 4); y4[e] = ((q0[0] + q0[1]) + (q0[2] + q0[3])) + ((q1[0] + q1[1]) + (q1[2] + q1[3])); } \
            float s = (y4[0] + y4[1]) + (y4[2] + y4[3]); s = red16(s); \
            const float mean = s * (1.0f / 64.0f); const f32x4 d = y4 - mean; \
            float q = (d[0] * d[0] + d[1] * d[1]) + (d[2] * d[2] + d[3] * d[3]); q = red16(q); \
            const float rstd = rsqrtf(q * (1.0f / 64.0f) + 64e-5f); \
            const f32x4 rr = *(const f32x4*)(buf_ + st * 384 + 256 + sc), km = *(const f32x4*)(buf_ + st * 384 + 192 + sc), vv = *(const f32x4*)(buf_ + st * 384 + 320 + sc); \
            const f32x4 bt = rr * km * rkc; float bonus = (bt[0] + bt[1]) + (bt[2] + bt[3]); bonus = red16(bonus); \
            f32x4 gg; gg[0] = bflo(g_r[0]); gg[1] = bfhi(g_r[0]); gg[2] = bflo(g_r[1]); gg[3] = bfhi(g_r[1]); \
            const f32x4 o = ((d * rstd) * lnw + lnb + bonus * vv) * gg; \
            u32x2 w; w.x = pk2(o[0], o[1]); w.y = pk2(o[2], o[3]); \
            const size_t row_ = (size_t)b * SEQ + (c) * TC + st; \
            *(u32x2*)(YC + row_ * 1024 + ch) = w; } while (0)
#define RW_GLOAD(c) do { const size_t row_ = (size_t)b * SEQ + (c) * TC + st; g_r = *(const u32x2*)(Gb + row_ * 512 + ch); } while (0)
        RW_LOAD(0);
        RW_WRITE(bufs);
        RW_LOAD(1);
        lds_barrier();
        for (int c = 0; c < NC; ++c) {
            if (c >= 1) { RW_POST(c - 1); }
            RW_GLOAD(c);
            if (c + 1 < NC) RW_WRITE(bufs + ((c + 1) & 1) * (TC * 384));
            if (c + 2 < NC) RW_LOAD(c + 2);
            lds_barrier();
        }
        RW_POST(NC - 1);
        lds_barrier();
#undef RW_LOAD
#undef RW_WRITE
#undef RW_POST
#undef RW_GLOAD
    }
}

__device__ __forceinline__ int tsw(int row, int col) { return row * 72 + (col ^ (((row >> 3) & 7) << 3)); }
__device__ __forceinline__ bf16x8 pack_acc2(const f32x4 a, const f32x4 b) {
    const unsigned x0 = pk2(a[0], a[1]), x1 = pk2(a[2], a[3]), x2 = pk2(b[0], b[1]), x3 = pk2(b[2], b[3]);
    const u32x4 u = {x0, x1, x2, x3}; return __builtin_bit_cast(bf16x8, u);
}
__device__ __forceinline__ bf16x8 ld_2x4(const bf16_t* p0, const bf16_t* p1) {
    const u32x2 lo = *(const u32x2*)p0, hi = *(const u32x2*)p1; const u32x4 u = {lo[0], lo[1], hi[0], hi[1]}; return __builtin_bit_cast(bf16x8, u);
}

__device__ __forceinline__ void retention_unit(KP p, const int unit, const int wvs) {
    const int b = unit >> 2, h = unit & 3;
    const int tid = launder_tid(wvs), wid = tid >> 6, lane = tid & 63, fr = lane & 15, fq = lane >> 4, tb = wid & 3, eh = wid >> 2;
    bf16_t* Qs = (bf16_t*)smem;
    bf16_t* Ks = Qs + 64 * 136;
    bf16_t* Vt = Ks + 64 * 136;
    bf16_t* Kt = Vt + 128 * 72;
    bf16_t* STs = Kt + 128 * 72;
    float* red = (float*)(STs + 128 * 136);
    const bf16_t* pret = (const bf16_t*)(p->ws + WS_C);
    const float* cosT = (const float*)(p->ws + WS_COS); const float* sinT = (const float*)(p->ws + WS_SIN);
    bf16_t* YC = (bf16_t*)(p->ws + WS_H);
    const float lg2 = log2f(1.0f - exp2f(-5.0f - (float)h));
    const float cd = exp2f(lg2 * 64.0f);
    for (int i = tid; i < 128 * 136 / 2; i += 512) ((unsigned*)STs)[i] = 0u;
    f32x4 accST[8];
#pragma unroll
    for (int i = 0; i < 8; ++i) accST[i] = (f32x4){0.f, 0.f, 0.f, 0.f};
    u32x2 q1[2], q2[2], k1[2], k2[2]; f32x4 cs[2], sn[2]; u32x4 vr[2];
#define RT_LOAD(c) do { for (int pp = 0; pp < 2; ++pp) { const int item = tid + pp * 512, t_ = item >> 4, i4 = (item & 15) * 4, pos = (c) * 64 + t_; \
            const bf16_t* pr_ = pret + ((size_t)b * SEQ + pos) * 2048 + h * 128 + i4; \
            q1[pp] = *(const u32x2*)(pr_); q2[pp] = *(const u32x2*)(pr_ + 64); k1[pp] = *(const u32x2*)(pr_ + 512); k2[pp] = *(const u32x2*)(pr_ + 512 + 64); \
            cs[pp] = *(const f32x4*)(cosT + pos * 64 + i4); sn[pp] = *(const f32x4*)(sinT + pos * 64 + i4); \
            const int e8 = (item & 15) * 8; vr[pp] = *(const u32x4*)(pret + ((size_t)b * SEQ + pos) * 2048 + 1024 + h * 128 + e8); } } while (0)
#define RT_WRITE() do { for (int pp = 0; pp < 2; ++pp) { const int item = tid + pp * 512, t_ = item >> 4, i4 = (item & 15) * 4; \
            f32x4 a1_, a2_; a1_[0] = bflo(q1[pp][0]); a1_[1] = bfhi(q1[pp][0]); a1_[2] = bflo(q1[pp][1]); a1_[3] = bfhi(q1[pp][1]); \
            a2_[0] = bflo(q2[pp][0]); a2_[1] = bfhi(q2[pp][0]); a2_[2] = bflo(q2[pp][1]); a2_[3] = bfhi(q2[pp][1]); \
            f32x4 o1_ = a1_ * cs[pp] - a2_ * sn[pp], o2_ = a1_ * sn[pp] + a2_ * cs[pp]; \
            u32x2 w_; w_.x = pk2(o1_[0], o1_[1]); w_.y = pk2(o1_[2], o1_[3]); *(u32x2*)(Qs + t_ * 136 + i4) = w_; \
            w_.x = pk2(o2_[0], o2_[1]); w_.y = pk2(o2_[2], o2_[3]); *(u32x2*)(Qs + t_ * 136 + 64 + i4) = w_; \
            a1_[0] = bflo(k1[pp][0]); a1_[1] = bfhi(k1[pp][0]); a1_[2] = bflo(k1[pp][1]); a1_[3] = bfhi(k1[pp][1]); \
            a2_[0] = bflo(k2[pp][0]); a2_[1] = bfhi(k2[pp][0]); a2_[2] = bflo(k2[pp][1]); a2_[3] = bfhi(k2[pp][1]); \
            o1_ = (a1_ * cs[pp] - a2_ * sn[pp]) * 0.08838834764831845f; o2_ = (a1_ * sn[pp] + a2_ * cs[pp]) * 0.08838834764831845f; \
            w_.x = pk2(o1_[0], o1_[1]); w_.y = pk2(o1_[2], o1_[3]); *(u32x2*)(Ks + t_ * 136 + i4) = w_; \
            w_.x = pk2(o2_[0], o2_[1]); w_.y = pk2(o2_[2], o2_[3]); *(u32x2*)(Ks + t_ * 136 + 64 + i4) = w_; \
            const float kd_ = exp2f(lg2 * (float)(63 - t_)); \
            for (int e = 0; e < 4; ++e) { Kt[tsw(i4 + e, t_)] = f2bf(o1_[e] * kd_); Kt[tsw(64 + i4 + e, t_)] = f2bf(o2_[e] * kd_); } \
            const int e8 = (item & 15) * 8; \
            for (int e = 0; e < 4; ++e) { Vt[tsw(e8 + 2 * e, t_)] = (bf16_t)(vr[pp][e] & 0xffffu); Vt[tsw(e8 + 2 * e + 1, t_)] = (bf16_t)(vr[pp][e] >> 16); } } } while (0)
    RT_LOAD(0);
    RT_WRITE();
    lds_barrier();
    for (int c = 0; c < SEQ / 64; ++c) {
        if (c + 1 < SEQ / 64) RT_LOAD(c + 1);
        bf16x8 qf[4];
#pragma unroll
        for (int ks = 0; ks < 4; ++ks) qf[ks] = *(const bf16x8*)(Qs + (tb * 16 + fr) * 136 + ks * 32 + fq * 8);
        f32x4 sT[4];
#pragma unroll
        for (int s_ = 0; s_ < 4; ++s_) { sT[s_] = (f32x4){0.f, 0.f, 0.f, 0.f};
#pragma unroll
            for (int ks = 0; ks < 4; ++ks) { const bf16x8 kf = *(const bf16x8*)(Ks + (s_ * 16 + fr) * 136 + ks * 32 + fq * 8);
                sT[s_] = __builtin_amdgcn_mfma_f32_16x16x32_bf16(kf, qf[ks], sT[s_], 0, 0, 0); } }
        const int tl = tb * 16 + fr;
#pragma unroll
        for (int s_ = 0; s_ < 4; ++s_)
#pragma unroll
            for (int r = 0; r < 4; ++r) { const int sl = s_ * 16 + fq * 4 + r; sT[s_][r] = (sl <= tl) ? sT[s_][r] * exp2f(lg2 * (float)(tl - sl)) : 0.f; }
        f32x4 acc[4];
#pragma unroll
        for (int et = 0; et < 4; ++et) { acc[et] = (f32x4){0.f, 0.f, 0.f, 0.f};
#pragma unroll
            for (int ks = 0; ks < 4; ++ks) { const bf16x8 sf = *(const bf16x8*)(STs + ((eh * 4 + et) * 16 + fr) * 136 + ks * 32 + fq * 8);
                acc[et] = __builtin_amdgcn_mfma_f32_16x16x32_bf16(sf, qf[ks], acc[et], 0, 0, 0); } }
        const float qd = exp2f(lg2 * (float)(tl + 1));
#pragma unroll
        for (int et = 0; et < 4; ++et) acc[et] = acc[et] * qd;
#pragma unroll
        for (int k2_ = 0; k2_ < 2; ++k2_) { const bf16x8 bfr = pack_acc2(sT[2 * k2_], sT[2 * k2_ + 1]);
#pragma unroll
            for (int et = 0; et < 4; ++et) { const int vr_ = (eh * 4 + et) * 16 + fr;
                const bf16x8 af = ld_2x4(Vt + tsw(vr_, (2 * k2_) * 16 + fq * 4), Vt + tsw(vr_, (2 * k2_ + 1) * 16 + fq * 4));
                acc[et] = __builtin_amdgcn_mfma_f32_16x16x32_bf16(af, bfr, acc[et], 0, 0, 0); } }
        float ss = 0.f;
#pragma unroll
        for (int et = 0; et < 4; ++et) ss += (acc[et][0] * acc[et][0] + acc[et][1] * acc[et][1]) + (acc[et][2] * acc[et][2] + acc[et][3] * acc[et][3]);
        ss += __shfl_xor(ss, 16); ss += __shfl_xor(ss, 32);
        if (fq == 0) red[eh * 64 + tl] = ss;
#pragma unroll
        for (int dt = 0; dt < 8; ++dt) accST[dt] = accST[dt] * cd;
#pragma unroll
        for (int ks = 0; ks < 2; ++ks) { const bf16x8 af = *(const bf16x8*)(Vt + tsw(wid * 16 + fr, ks * 32 + fq * 8));
#pragma unroll
            for (int dt = 0; dt < 8; ++dt) { const bf16x8 bfr = *(const bf16x8*)(Kt + tsw(dt * 16 + fr, ks * 32 + fq * 8));
                accST[dt] = __builtin_amdgcn_mfma_f32_16x16x32_bf16(af, bfr, accST[dt], 0, 0, 0); } }
        lds_barrier();
        {
            const float tot = red[tl] + red[64 + tl];
            const float rn = rsqrtf(tot * (1.0f / 128.0f) + 1e-6f);
            const size_t row_ = (size_t)b * SEQ + c * 64 + tl;
#pragma unroll
            for (int et = 0; et < 4; ++et) { const int e0 = (eh * 4 + et) * 16 + fq * 4;
                const u32x2 gr = *(const u32x2*)(pret + row_ * 2048 + 1536 + h * 128 + e0);
                f32x4 g; g[0] = bflo(gr[0]); g[1] = bfhi(gr[0]); g[2] = bflo(gr[1]); g[3] = bfhi(gr[1]);
                f32x4 o; for (int r = 0; r < 4; ++r) o[r] = acc[et][r] * rn * (g[r] * sigmoidf_(g[r]));
                u32x2 w; w.x = pk2(o[0], o[1]); w.y = pk2(o[2], o[3]);
                *(u32x2*)(YC + row_ * 1024 + 512 + h * 128 + e0) = w; }
        }
#pragma unroll
        for (int dt = 0; dt < 8; ++dt)
#pragma unroll
            for (int r = 0; r < 4; ++r) STs[(wid * 16 + fq * 4 + r) * 136 + dt * 16 + fr] = f2bf(accST[dt][r]);
        if (c + 1 < SEQ / 64) RT_WRITE();
        lds_barrier();
    }
#undef RT_LOAD
#undef RT_WRITE
}

__device__ __forceinline__ float softcapf(float x) { const float e = __expf(2.f * x * (1.0f / 15.0f)); return 15.0f * (1.f - 2.f / (e + 1.f)); }

__device__ __forceinline__ void mlstm_unit(KP p, const int unit, const int wvs) {
    const int par = unit & 1, bh = unit >> 1, b = bh >> 3, h = bh & 7;
    const int tid = launder_tid(wvs), wid = tid >> 6, lane = tid & 63, fr = lane & 15, fq = lane >> 4, tb = wid & 3, eh = wid >> 2;
    bf16_t* Qs = (bf16_t*)smem;
    bf16_t* Ks = Qs + 64 * 72;
    bf16_t* Vt = Ks + 64 * 72;
    bf16_t* Kt = Vt + 144 * 72;
    bf16_t* CTs = Kt + 64 * 72;
    float* red = (float*)(CTs + 144 * 72);
    float* cwl = red + 128;
    float* nwl = cwl + 640;
    float* Gs = nwl + 128;
    float* Mx = Gs + 64 * 68;
    float* Ee = Mx + 64 * 68;
    const bf16_t* pc = (const bf16_t*)(p->ws + WS_D);
    const float* gates = (const float*)(p->ws + WS_GATES);
    bf16_t* YC = (bf16_t*)(p->ws + WS_H);
    for (int i = tid; i < 144 * 72 / 2; i += 512) ((unsigned*)CTs)[i] = 0u;
    for (int i = tid; i < 16 * 72 / 2; i += 512) ((unsigned*)(Vt + 128 * 72))[i] = (i < 36) ? 0x3F803F80u : 0u;
    for (int i = tid; i < 640; i += 512) { const int j = i >> 7, cc = i & 127; const int col = (cc >> 6) * 512 + h * 64 + (cc & 63);
        cwl[i] = (j < 4) ? p->c_conv_w[j * 1024 + col] : p->c_conv_b[col]; }
    if (tid < 128) nwl[tid] = p->c_norm_w[h * 128 + tid];
    if (wid == 0) {
        const float ibias = p->c_i_bias[h], fbias = p->c_f_bias[h];
        const float* gr = gates + ((size_t)b * SEQ + lane * 64) * 16 + h;
        float bsum = 0.f;
        for (int i = 0; i < 64; ++i) { const float li = softcapf(gr[i * 16] + ibias), lf = -log1pf(__expf(-softcapf(gr[i * 16 + 8] + fbias)));
            bsum += lf; Gs[lane * 68 + i] = li; Ee[lane * 68 + i] = lf; }
        float inc = bsum;
        for (int o = 1; o < 64; o <<= 1) { const float n_ = __shfl_up(inc, o); if (lane >= o) inc += n_; }
        float Bc = inc - bsum, lmax = -3.0e38f;
        for (int i = 0; i < 64; ++i) { Bc += Ee[lane * 68 + i]; const float g = Gs[lane * 68 + i] - Bc; Gs[lane * 68 + i] = g; Ee[lane * 68 + i] = Bc; lmax = fmaxf(lmax, g); }
        float pm = lmax;
        for (int o = 1; o < 64; o <<= 1) { const float n_ = __shfl_up(pm, o); if (lane >= o) pm = fmaxf(pm, n_); }
        float run = __shfl_up(pm, 1); if (lane == 0) run = 0.f; run = fmaxf(run, 0.f);
        for (int i = 0; i < 64; ++i) { run = fmaxf(run, Gs[lane * 68 + i]); Mx[lane * 68 + i] = run; Ee[lane * 68 + i] += run; }
    }
    f32x4 accC[4], accCa;
#pragma unroll
    for (int i = 0; i < 4; ++i) accC[i] = (f32x4){0.f, 0.f, 0.f, 0.f};
    accCa = (f32x4){0.f, 0.f, 0.f, 0.f};
    const int gidx = tid & 15, isK = gidx >> 3, c8 = (gidx & 7) * 8, ccol = isK * 512 + h * 64 + c8, lcol = isK * 64 + c8;
    const int tK = tid >> 3, c8K = (tid & 7) * 8, ccolK = 512 + h * 64 + c8K, lcolK = 64 + c8K;
    u32x4 xr[2][4]; u32x4 vr[2]; u32x2 og[4];
#define ML_LDX(dst, t_, pos_, col_) do { const bf16_t* pr_ = pc + ((size_t)b * SEQ + (pos_)) * 3072; \
        for (int j = 0; j < 4; ++j) { if ((pos_) - 3 + j >= 0) dst[j] = *(const u32x4*)(pr_ + (long)(j - 3) * 3072 + (col_)); else dst[j] = (u32x4){0u, 0u, 0u, 0u}; } } while (0)
#define ML_LOAD(c) do { if ((((c) & 1) == par)) { for (int pp = 0; pp < 2; ++pp) { const int t_ = (tid + pp * 512) >> 4; ML_LDX(xr[pp], t_, (c) * 64 + t_, ccol); } } \
        else { ML_LDX(xr[0], tK, (c) * 64 + tK, ccolK); } \
        for (int pp = 0; pp < 2; ++pp) { const int item = tid + pp * 512, t_ = item >> 4, e8 = (item & 15) * 8; \
            vr[pp] = *(const u32x4*)(pc + ((size_t)b * SEQ + (c) * 64 + t_) * 3072 + 1024 + h * 128 + e8); } } while (0)
#define ML_CONV(src, lcol_, y_) do { \
            { const f32x4 b0_ = *(const f32x4*)(cwl + 512 + (lcol_)), b1_ = *(const f32x4*)(cwl + 512 + (lcol_) + 4); \
              y_[0] = b0_[0]; y_[1] = b0_[1]; y_[2] = b0_[2]; y_[3] = b0_[3]; y_[4] = b1_[0]; y_[5] = b1_[1]; y_[6] = b1_[2]; y_[7] = b1_[3]; } \
            for (int j = 0; j < 4; ++j) { const f32x4 w0_ = *(const f32x4*)(cwl + j * 128 + (lcol_)), w1_ = *(const f32x4*)(cwl + j * 128 + (lcol_) + 4); \
                y_[0] += w0_[0] * bflo(src[j][0]); y_[1] += w0_[1] * bfhi(src[j][0]); y_[2] += w0_[2] * bflo(src[j][1]); y_[3] += w0_[3] * bfhi(src[j][1]); \
                y_[4] += w1_[0] * bflo(src[j][2]); y_[5] += w1_[1] * bfhi(src[j][2]); y_[6] += w1_[2] * bflo(src[j][3]); y_[7] += w1_[3] * bfhi(src[j][3]); } \
            for (int e = 0; e < 8; ++e) y_[e] = y_[e] * sigmoid_fast(y_[e]); } while (0)
#define ML_KOUT(y_, t_, c8_) do { for (int e = 0; e < 8; ++e) y_[e] *= 0.125f; \
                u32x4 o_; o_.x = pk2(y_[0], y_[1]); o_.y = pk2(y_[2], y_[3]); o_.z = pk2(y_[4], y_[5]); o_.w = pk2(y_[6], y_[7]); *(u32x4*)(Ks + (t_) * 72 + (c8_)) = o_; \
                const float kw_ = __expf(ga_[(t_)] - M63_); for (int e = 0; e < 8; ++e) Kt[tsw((c8_) + e, (t_))] = f2bf(y_[e] * kw_); } while (0)
#define ML_WRITE(c) do { const float* ga_ = Gs + (c) * 68; const float M63_ = Mx[(c) * 68 + 63]; \
        if ((((c) & 1) == par)) { for (int pp = 0; pp < 2; ++pp) { const int t_ = (tid + pp * 512) >> 4; float y_[8]; ML_CONV(xr[pp], lcol, y_); \
                if (isK == 0) { u32x4 o_; o_.x = pk2(y_[0], y_[1]); o_.y = pk2(y_[2], y_[3]); o_.z = pk2(y_[4], y_[5]); o_.w = pk2(y_[6], y_[7]); *(u32x4*)(Qs + t_ * 72 + c8) = o_; } \
                else ML_KOUT(y_, t_, c8); } } \
        else { float y_[8]; ML_CONV(xr[0], lcolK, y_); ML_KOUT(y_, tK, c8K); } \
        for (int pp = 0; pp < 2; ++pp) { const int item = tid + pp * 512, t_ = item >> 4, e8 = (item & 15) * 8; \
            for (int e = 0; e < 4; ++e) { Vt[tsw(e8 + 2 * e, t_)] = (bf16_t)(vr[pp][e] & 0xffffu); Vt[tsw(e8 + 2 * e + 1, t_)] = (bf16_t)(vr[pp][e] >> 16); } } } while (0)
    ML_LOAD(0);
    lds_barrier();
    ML_WRITE(0);
    lds_barrier();
    for (int c = 0; c < SEQ / 64; ++c) {
        const float* ga = Gs + c * 68;
        const bool own = ((c & 1) == par);
        if (c + 1 < SEQ / 64) ML_LOAD(c + 1);
        const int tl = tb * 16 + fr;
        const float M63 = Mx[c * 68 + 63];
        const float Mprev = (c == 0) ? 0.f : Mx[(c - 1) * 68 + 63];
        f32x4 acc[5];
        if (own) {
            {
                const size_t row_ = (size_t)b * SEQ + c * 64 + tl;
#pragma unroll
                for (int et = 0; et < 4; ++et) og[et] = *(const u32x2*)(pc + row_ * 3072 + 2048 + h * 128 + (eh * 4 + et) * 16 + fq * 4);
            }
            bf16x8 qf[2];
#pragma unroll
            for (int ks = 0; ks < 2; ++ks) qf[ks] = *(const bf16x8*)(Qs + tl * 72 + ks * 32 + fq * 8);
            f32x4 sT[4];
#pragma unroll
            for (int s_ = 0; s_ < 4; ++s_) { sT[s_] = (f32x4){0.f, 0.f, 0.f, 0.f};
#pragma unroll
                for (int ks = 0; ks < 2; ++ks) { const bf16x8 kf = *(const bf16x8*)(Ks + (s_ * 16 + fr) * 72 + ks * 32 + fq * 8);
                    sT[s_] = __builtin_amdgcn_mfma_f32_16x16x32_bf16(kf, qf[ks], sT[s_], 0, 0, 0); } }
            const float Mt = Mx[c * 68 + tl], Et = Ee[c * 68 + tl];
#pragma unroll
            for (int s_ = 0; s_ < 4; ++s_) { const f32x4 g4 = *(const f32x4*)(ga + s_ * 16 + fq * 4);
#pragma unroll
                for (int r = 0; r < 4; ++r) { const int sl = s_ * 16 + fq * 4 + r; sT[s_][r] = (sl <= tl) ? sT[s_][r] * __expf(g4[r] - Mt) : 0.f; } }
#pragma unroll
            for (int et = 0; et < 5; ++et) { acc[et] = (f32x4){0.f, 0.f, 0.f, 0.f}; const int etile = (et < 4) ? (eh * 4 + et) : 8;
#pragma unroll
                for (int ks = 0; ks < 2; ++ks) { const bf16x8 cf = *(const bf16x8*)(CTs + (etile * 16 + fr) * 72 + ks * 32 + fq * 8);
                    acc[et] = __builtin_amdgcn_mfma_f32_16x16x32_bf16(cf, qf[ks], acc[et], 0, 0, 0); } }
            const float inter = __expf(Mprev - Mt);
#pragma unroll
            for (int et = 0; et < 5; ++et) acc[et] = acc[et] * inter;
#pragma unroll
            for (int k2_ = 0; k2_ < 2; ++k2_) { const bf16x8 bfr = pack_acc2(sT[2 * k2_], sT[2 * k2_ + 1]);
#pragma unroll
                for (int et = 0; et < 5; ++et) { const int etile = (et < 4) ? (eh * 4 + et) : 8; const int vr_ = etile * 16 + fr;
                    const bf16x8 af = ld_2x4(Vt + tsw(vr_, (2 * k2_) * 16 + fq * 4), Vt + tsw(vr_, (2 * k2_ + 1) * 16 + fq * 4));
                    acc[et] = __builtin_amdgcn_mfma_f32_16x16x32_bf16(af, bfr, acc[et], 0, 0, 0); } }
            const float den = __shfl(acc[4][0], fr);
            const float dn = 1.0f / fmaxf(fabsf(den), __expf(-Et));
            float ss = 0.f;
#pragma unroll
            for (int et = 0; et < 4; ++et) { acc[et] = acc[et] * dn; ss += (acc[et][0] * acc[et][0] + acc[et][1] * acc[et][1]) + (acc[et][2] * acc[et][2] + acc[et][3] * acc[et][3]); }
            ss += __shfl_xor(ss, 16); ss += __shfl_xor(ss, 32);
            if (fq == 0) red[eh * 64 + tl] = ss;
        }
        const float csc = __expf(Mprev - M63);
#pragma unroll
        for (int dt = 0; dt < 4; ++dt) accC[dt] = accC[dt] * csc;
        accCa = accCa * csc;
#pragma unroll
        for (int ks = 0; ks < 2; ++ks) { const bf16x8 af = *(const bf16x8*)(Vt + tsw(wid * 16 + fr, ks * 32 + fq * 8));
#pragma unroll
            for (int dt = 0; dt < 4; ++dt) { const bf16x8 bfr = *(const bf16x8*)(Kt + tsw(dt * 16 + fr, ks * 32 + fq * 8));
                accC[dt] = __builtin_amdgcn_mfma_f32_16x16x32_bf16(af, bfr, accC[dt], 0, 0, 0); }
            if (wid < 4) { const bf16x8 aa = *(const bf16x8*)(Vt + tsw(128 + fr, ks * 32 + fq * 8)), bb = *(const bf16x8*)(Kt + tsw(wid * 16 + fr, ks * 32 + fq * 8));
                accCa = __builtin_amdgcn_mfma_f32_16x16x32_bf16(aa, bb, accCa, 0, 0, 0); } }
        lds_barrier();
        if (own) {
            const float tot = red[tl] + red[64 + tl];
            const float rn = rsqrtf(tot * (1.0f / 128.0f) + 1e-6f);
            const size_t row_ = (size_t)b * SEQ + c * 64 + tl;
#pragma unroll
            for (int et = 0; et < 4; ++et) { const int e0 = (eh * 4 + et) * 16 + fq * 4;
                const f32x4 nw = *(const f32x4*)(nwl + e0);
                f32x4 ogf; ogf[0] = bflo(og[et][0]); ogf[1] = bfhi(og[et][0]); ogf[2] = bflo(og[et][1]); ogf[3] = bfhi(og[et][1]);
                f32x4 o; for (int r = 0; r < 4; ++r) o[r] = acc[et][r] * rn * nw[r] * sigmoid_fast(ogf[r]);
                u32x2 w; w.x = pk2(o[0], o[1]); w.y = pk2(o[2], o[3]);
                *(u32x2*)(YC + row_ * 1024 + h * 128 + e0) = w; }
        }
        if (!own) {
#pragma unroll
            for (int dt = 0; dt < 4; ++dt)
#pragma unroll
                for (int r = 0; r < 4; ++r) CTs[(wid * 16 + fq * 4 + r) * 72 + dt * 16 + fr] = f2bf(accC[dt][r]);
            if (wid < 4) {
#pragma unroll
                for (int r = 0; r < 4; ++r) CTs[(128 + fq * 4 + r) * 72 + wid * 16 + fr] = f2bf(accCa[r]);
            }
        }
        if (c + 1 < SEQ / 64) ML_WRITE(c + 1);
        lds_barrier();
    }
#undef ML_LDX
#undef ML_LOAD
#undef ML_CONV
#undef ML_KOUT
#undef ML_WRITE
}

__device__ __forceinline__ void late_weights(KP p, const int wvs, const int bid, const int nb) {
    unsigned char* ws = p->ws;
    transpose_job(p->ab_w_out, (bf16_t*)(ws + WS_WT_ABO), 1024, 1024, 1024, wvs, bid, nb);
    transpose_job(p->mlp_w1, (bf16_t*)(ws + WS_WT_W1_0), 1024, 4096, 4096, wvs, bid, nb, p->norm_mlp_g);
    transpose_job(p->mlp_w2, (bf16_t*)(ws + WS_WT_W2_0), 4096, 1024, 1024, wvs, bid, nb);
    transpose_job(p->c_w_in, (bf16_t*)(ws + WS_WT_C), 1024, 3088, 3328, wvs, bid, nb, p->norm_mix_g + 1024);
    transpose_job(p->c_w_out, (bf16_t*)(ws + WS_WT_CO), 1024, 1024, 1024, wvs, bid, nb);
    transpose_job(p->mlp_w1 + (size_t)1024 * 4096, (bf16_t*)(ws + WS_WT_W1_1), 1024, 4096, 4096, wvs, bid, nb, p->norm_mlp_g + 1024);
    transpose_job(p->mlp_w2 + (size_t)1024 * 4096, (bf16_t*)(ws + WS_WT_W2_1), 4096, 1024, 1024, wvs, bid, nb);
}

#define XB_TMO      128
#define XB_XCNT(j)  (256  + 64 * (j))
#define XB_XSUB(j)  (1280 + 64 * (j))
#define XB_XGEN(j)  (2304 + 64 * (j))
#define XB_TOP      3328
#define XB_TOPGEN   3392
#define XB_SPIN_CAP (1u << 18)
typedef __attribute__((address_space(3))) unsigned lds_uword;
__device__ __forceinline__ unsigned xb_ld(unsigned* p)              { return __hip_atomic_load(p, __ATOMIC_RELAXED, __HIP_MEMORY_SCOPE_AGENT); }
__device__ __forceinline__ unsigned xb_add(unsigned* p, unsigned v) { return __hip_atomic_fetch_add(p, v, __ATOMIC_RELAXED, __HIP_MEMORY_SCOPE_AGENT); }
__device__ __forceinline__ unsigned xb_xcc_id() { return (unsigned)__builtin_amdgcn_s_getreg((3 << 11) | 20) & 0xFu; }
#define XB_SPIN(cond, bar) do { unsigned _sp = 0; while (cond) { if (_sp < 48u) __builtin_amdgcn_s_sleep(1); else __builtin_amdgcn_s_sleep(24); \
    if ((++_sp & 255u) == 0u) { if (xb_ld(&(bar)[XB_TMO])) break; if (_sp > XB_SPIN_CAP) { atomicAdd(&(bar)[XB_TMO], 1u); break; } } } } while (0)
struct XcdBarrier { unsigned* bar; unsigned x; volatile lds_uword* st; };
__device__ __forceinline__ void xcd_barrier_complete(unsigned* bar, unsigned x, unsigned& nloc, unsigned& nx) {
    const unsigned G = gridDim.x;
    unsigned sum, cnt, mine, sp = 0u;
    for (;;) {
        sum = 0u; cnt = 0u; mine = 0u;
#pragma unroll
        for (unsigned j = 0; j < 16; ++j) { const unsigned c = xb_ld(&bar[XB_XCNT(j)]); sum += c; cnt += (c > 0u) ? 1u : 0u; mine = (j == x) ? c : mine; }
        if (sum == G) break;
        __builtin_amdgcn_s_sleep(1);
        if ((++sp & 255u) == 0u) { if (xb_ld(&bar[XB_TMO])) break; if (sp > XB_SPIN_CAP) { atomicAdd(&bar[XB_TMO], 1u); break; } }
    }
    nloc = mine > 0u ? mine : 1u; nx = cnt > 0u ? cnt : 1u;
}
__device__ __forceinline__ void xcd_barrier(const XcdBarrier& b, const int wvs) {
    asm volatile("s_waitcnt vmcnt(0)" ::: "memory");
    __syncthreads();
    if (launder_tid(wvs) == 0) {
        unsigned* bar = b.bar;
        __builtin_amdgcn_s_waitcnt(0);
        unsigned nloc = b.st[0], nx = b.st[1];
        if (nloc == 0u) { xcd_barrier_complete(bar, b.x, nloc, nx); b.st[0] = nloc; b.st[1] = nx; }
        const unsigned old = xb_add(&bar[XB_XSUB(b.x)], 1u);
        const unsigned gen = old / nloc;
        if (old + 1u == (gen + 1u) * nloc) {
            __builtin_amdgcn_fence(__ATOMIC_RELEASE, "agent");
            asm volatile("s_waitcnt vmcnt(0)" ::: "memory");
            const unsigned og = xb_add(&bar[XB_TOP], 1u);
            const unsigned tg = og / nx;
            if (og + 1u == (tg + 1u) * nx) xb_add(&bar[XB_TOPGEN], 1u);
            else XB_SPIN(xb_ld(&bar[XB_TOPGEN]) == tg, bar);
            __builtin_amdgcn_fence(__ATOMIC_ACQUIRE, "agent");
            xb_add(&bar[XB_XGEN(b.x)], 1u);
            asm volatile("s_waitcnt vmcnt(0)" ::: "memory");
        } else {
            XB_SPIN(xb_ld(&bar[XB_XGEN(b.x)]) == gen, bar);
            __builtin_amdgcn_fence(__ATOMIC_ACQUIRE, "agent");
            asm volatile("s_waitcnt vmcnt(0)" ::: "memory");
        }
    }
    __syncthreads();
}

__global__ void __launch_bounds__(512) fwd_megakernel(const Params p_unused) {
    cg::grid_group grid = cg::this_grid();
    const KP kp0 = (KP)__builtin_amdgcn_kernarg_segment_ptr();
    const int wvs = __builtin_amdgcn_readfirstlane((int)(threadIdx.x >> 6));
    XcdBarrier xbar; xbar.bar = (unsigned*)(launder(kp0)->ws + WS_BAR); xbar.x = xb_xcc_id(); xbar.st = (volatile lds_uword*)(smem + GEMM_LDS);
    if (launder_tid(wvs) == 0) { xbar.st[0] = 0u; xbar.st[1] = 0u; (void)xb_add(&xbar.bar[XB_XCNT(xbar.x)], 1u); }
#define WSP (launder(kp0)->ws)
    prologue_phase(launder(kp0), wvs);
    grid.sync();
    { unsigned char* ws = WSP; gemm_phase<3840, 1024>((const bf16_t*)(ws + WS_H), (const bf16_t*)(ws + WS_WT_AB), EpiP0{(bf16_t*)(ws + WS_D_PRW), (bf16_t*)(ws + WS_C)}, wvs); }
    xcd_barrier(xbar, wvs);
    lora_in_phase(launder(kp0), wvs);
    xcd_barrier(xbar, wvs);
    { KP p = launder(kp0); unsigned char* ws = p->ws; gemm_phase<1536, 128, EpiLora, 256, true>((const bf16_t*)(ws + WS_D_L), (const bf16_t*)(ws + WS_WT_LORA),
               EpiLora{(bf16_t*)(ws + WS_D_W)}, wvs); }
    xcd_barrier(xbar, wvs);
    if (blockIdx.x < 128) rwkv_scan_unit(launder(kp0), blockIdx.x, wvs);
    else if (blockIdx.x < 192) retention_unit(launder(kp0), blockIdx.x - 128, wvs);
    else if (blockIdx.x < 256) late_weights(launder(kp0), wvs, blockIdx.x - 192, 64);
    xcd_barrier(xbar, wvs);
    { KP p = launder(kp0); unsigned char* ws = p->ws; gemm_phase<1024, 1024>((const bf16_t*)(ws + WS_H), (const bf16_t*)(ws + WS_WT_ABO), EpiResidIn{p->x, (bf16_t*)(ws + WS_C), (unsigned long long*)(ws + WS_R2)}, wvs); }
    xcd_barrier(xbar, wvs);
    { unsigned char* ws = WSP; gemm_phase<4096, 1024>((const bf16_t*)(ws + WS_C), (const bf16_t*)(ws + WS_WT_W1_0), EpiRelu2{(bf16_t*)(ws + WS_D), (const unsigned long long*)(ws + WS_R2)}, wvs); }
    xcd_barrier(xbar, wvs);
    { unsigned char* ws = WSP; gemm_phase<1024, 4096>((const bf16_t*)(ws + WS_D), (const bf16_t*)(ws + WS_WT_W2_0), EpiResidN{(bf16_t*)(ws + WS_C), (unsigned long long*)(ws + WS_R2) + MTOK}, wvs); }
    xcd_barrier(xbar, wvs);
    { unsigned char* ws = WSP; gemm_phase<3328, 1024, EpiC, 1024, false, true>((const bf16_t*)(ws + WS_C), (const bf16_t*)(ws + WS_WT_C), EpiC{(bf16_t*)(ws + WS_D), (float*)(ws + WS_GATES), (const unsigned long long*)(ws + WS_R2) + MTOK}, wvs); }
    xcd_barrier(xbar, wvs);
    if (blockIdx.x < 256) mlstm_unit(launder(kp0), blockIdx.x, wvs);
    xcd_barrier(xbar, wvs);
    { unsigned char* ws = WSP; gemm_phase<1024, 1024>((const bf16_t*)(ws + WS_H), (const bf16_t*)(ws + WS_WT_CO), EpiResidN{(bf16_t*)(ws + WS_C), (unsigned long long*)(ws + WS_R2) + 2 * MTOK}, wvs); }
    xcd_barrier(xbar, wvs);
    { unsigned char* ws = WSP; gemm_phase<4096, 1024>((const bf16_t*)(ws + WS_C), (const bf16_t*)(ws + WS_WT_W1_1), EpiRelu2{(bf16_t*)(ws + WS_D), (const unsigned long long*)(ws + WS_R2) + 2 * MTOK}, wvs); }
    xcd_barrier(xbar, wvs);
    { unsigned char* ws = WSP; gemm_phase<1024, 4096>((const bf16_t*)(ws + WS_D), (const bf16_t*)(ws + WS_WT_W2_1), EpiResid{(bf16_t*)(ws + WS_C)}, wvs); }
    xcd_barrier(xbar, wvs);
    { KP p = launder(kp0); unsigned char* ws = p->ws; norm_phase_b((const bf16_t*)(ws + WS_C), p->norm_final_g, nullptr, p->out, wvs); }
#undef WSP
}

extern "C" void kernel_launch(void* const* d_in, const int* in_sizes, int n_in, void* d_out, int out_size, void* d_ws, size_t ws_size, hipStream_t stream) {
    constexpr int LDS_BYTES = GEMM_LDS + 64 + 1024;
    static int grid_blocks = 0;
    if (!grid_blocks) {
        int dev = 0, cus = 0, per_cu = 0;
        hipGetDevice(&dev);
        hipDeviceGetAttribute(&cus, hipDeviceAttributeMultiprocessorCount, dev);
        hipFuncSetAttribute((const void*)fwd_megakernel, hipFuncAttributeMaxDynamicSharedMemorySize, LDS_BYTES);
        hipOccupancyMaxActiveBlocksPerMultiprocessor(&per_cu, (const void*)fwd_megakernel, 512, LDS_BYTES);
        if (per_cu < 1) per_cu = 1;
        grid_blocks = cus;
        if (grid_blocks != 256) fprintf(stderr, "kernel_launch: expected 256 CUs, got %d\n", grid_blocks);
    }
    (void)hipMemsetAsync((unsigned char*)d_ws + WS_BAR, 0, WS_BAR_BYTES, stream);
    Params hp{};
    const float** pp = (const float**)&hp;
    for (int i = 0; i < 26; ++i) pp[i] = (const float*)d_in[i];
    hp.out = (float*)d_out; hp.ws = (unsigned char*)d_ws;
    void* args[] = {&hp};
    hipError_t e = hipLaunchCooperativeKernel((const void*)fwd_megakernel, dim3(grid_blocks), dim3(512), args, LDS_BYTES, stream);
    if (e != hipSuccess) fprintf(stderr, "cooperative launch failed: %s (grid %d)\n", hipGetErrorString(e), grid_blocks);
}
```
